# Optimizing an MI355X kernel written in HIP

```python
import math
import jax
import jax.numpy as jnp
from jax import lax

D_MODEL = 1024
BATCH = 32
SEQ = 2048
DEPTH = 4

CTX_LEN = 256
GRID_W = 64
D_MIX = D_MODEL
DIFF_HEADS = 4
DIFF_HEAD_DIM = 32
DIFF_V_DIM = 2 * DIFF_HEAD_DIM
DIFF_WIDTH = DIFF_HEADS * DIFF_V_DIM
HGRN_HEADS = 4
HGRN_K = 128
HGRN_V = 128
HGRN_WIDTH = HGRN_HEADS * HGRN_V
HGRN_CHUNK = 32
SWA_Q_HEADS = 4
SWA_KV_HEADS = 2
SWA_GROUP = SWA_Q_HEADS // SWA_KV_HEADS
SWA_HEAD_DIM = 64
SWA_WIDTH = SWA_Q_HEADS * SWA_HEAD_DIM
WINDOW = 128
Q_BLOCK = 128
D_FF = 2816
N_EXPERTS = 8
TOP_K = 2
ROPE_BASE = 10000.0
NORM_EPS = 1e-6
IN_SIZES = (DIFF_WIDTH,) * 3 + (HGRN_WIDTH,) * 5 + (SWA_WIDTH, SWA_KV_HEADS * SWA_HEAD_DIM, SWA_KV_HEADS * SWA_HEAD_DIM)
D_IN = sum(IN_SIZES)
N_DENSE = (DEPTH + 1) // 2
N_MOE = DEPTH // 2
F32 = jnp.float32

kernel_name = 'hymba_style_diffusion_hybrid_trunk'


def rmsnorm(x, g):
    xf = x.astype(F32)
    y = xf * lax.rsqrt(jnp.mean(xf * xf, axis=-1, keepdims=True) + NORM_EPS)
    return (y * g.astype(F32)).astype(x.dtype)


def grid_positions(n_tokens):
    rows = n_tokens // GRID_W
    row = jnp.repeat(jnp.arange(rows, dtype=jnp.int32), GRID_W)
    col = jnp.tile(jnp.arange(GRID_W, dtype=jnp.int32), rows)
    return row, col


def _rotate(xp, pos):
    nf = xp.shape[-1] // 2
    inv = ROPE_BASE ** (-jnp.arange(nf, dtype=F32) / nf)
    ang = pos.astype(F32)[:, None] * inv[None, :]
    shape = (1, pos.shape[0]) + (1,) * (xp.ndim - 3) + (nf,)
    cos = jnp.cos(ang).reshape(shape).astype(xp.dtype)
    sin = jnp.sin(ang).reshape(shape).astype(xp.dtype)
    x1, x2 = xp[..., :nf], xp[..., nf:]
    return jnp.concatenate([x1 * cos - x2 * sin, x1 * sin + x2 * cos], axis=-1)


def axial_rope(x, row, col):
    half = x.shape[-1] // 2
    return jnp.concatenate([_rotate(x[..., :half], row), _rotate(x[..., half:], col)], axis=-1)


def map_query_blocks(fn, q):
    b, n = q.shape[:2]
    nb = n // Q_BLOCK
    qb = jnp.moveaxis(q.reshape((b, nb, Q_BLOCK) + q.shape[2:]), 1, 0)
    out = lax.map(lambda a: fn(a[0], a[1]), (qb, jnp.arange(nb, dtype=jnp.int32)))
    out = jnp.moveaxis(out, 0, 1)
    return out.reshape((b, n) + out.shape[3:])


def split_projection(h, w):
    p = jnp.einsum('bld,de->ble', h, w)
    points, acc = [], 0
    for s in IN_SIZES[:-1]:
        acc += s
        points.append(acc)
    return jnp.split(p, points, axis=-1)


def _diff_core(q, k, v, lam):
    s = jnp.einsum('bqhmd,bkhmd->bhmqk', q, k, preferred_element_type=F32) * (DIFF_HEAD_DIM ** -0.5)
    p = jax.nn.softmax(s, axis=-1)
    a = p[:, :, 0] - lam * p[:, :, 1]
    return jnp.einsum('bhqk,bkhe->bqhe', a.astype(v.dtype), v)


def diff_attention_mixer(lat, ctx, row, col, qk_g, lam_vec, lam_init, sub_g, need_ctx):
    def prep(q, k, v, rotary):
        b, n, _ = q.shape
        q = rmsnorm(q.reshape(b, n, DIFF_HEADS, 2, DIFF_HEAD_DIM), qk_g[0])
        k = rmsnorm(k.reshape(b, n, DIFF_HEADS, 2, DIFF_HEAD_DIM), qk_g[1])
        if rotary:
            q, k = axial_rope(q, row, col), axial_rope(k, row, col)
        return q, k, v.reshape(b, n, DIFF_HEADS, DIFF_V_DIM)

    q_l, k_l, v_l = prep(*lat, True)
    q_c, k_c, v_c = prep(*ctx, False)
    lv = lam_vec.astype(F32)
    lam = jnp.exp(jnp.sum(lv[0] * lv[1])) - jnp.exp(jnp.sum(lv[2] * lv[3])) + lam_init
    k_all = jnp.concatenate([k_c, k_l], axis=1)
    v_all = jnp.concatenate([v_c, v_l], axis=1)

    def post(o):
        b, n = o.shape[:2]
        return (rmsnorm(o, sub_g) * (1.0 - lam_init)).reshape(b, n, DIFF_WIDTH)

    o_l = post(map_query_blocks(lambda qb, i: _diff_core(qb, k_all, v_all, lam), q_l))
    o_c = post(_diff_core(q_c, k_c, v_c, lam)) if need_ctx else None
    return o_l, o_c


def _hgrn_gates(f_logit, lb):
    lb = lb.reshape(HGRN_HEADS, HGRN_K).astype(F32)
    log_f = jnp.logaddexp(jnp.log(lb), jnp.log1p(-lb) + jax.nn.log_sigmoid(f_logit))
    return -jnp.expm1(log_f), log_f


def _hgrn2_chunkwise(q, k, v, log_f, s0):
    b, n, h, kd = q.shape
    nc = n // HGRN_CHUNK

    def to_chunks(t):
        return jnp.moveaxis(t.reshape(b, nc, HGRN_CHUNK, h, t.shape[-1]), 1, 0)

    causal = jnp.tril(jnp.ones((HGRN_CHUNK, HGRN_CHUNK), dtype=bool))[None, :, :, None, None]

    def step(s, inp):
        qc, kc, vc, lfc = inp
        cum = jnp.cumsum(lfc, axis=1)
        dec = jnp.exp(jnp.where(causal, cum[:, :, None] - cum[:, None], -jnp.inf))
        scores = jnp.sum(qc[:, :, None] * kc[:, None] * dec, axis=-1)
        o = jnp.einsum('btsh,bshv->bthv', scores, vc)
        o = o + jnp.einsum('bthk,bhkv->bthv', qc * jnp.exp(cum), s)
        last = cum[:, -1]
        k_dec = kc * jnp.exp(last[:, None] - cum)
        s_new = jnp.exp(last)[..., None] * s + jnp.einsum('bshk,bshv->bhkv', k_dec, vc)
        return s_new, o

    s_fin, o = lax.scan(step, s0, (to_chunks(q), to_chunks(k), to_chunks(v), to_chunks(log_f)))
    o = jnp.moveaxis(o, 0, 1).reshape(b, n, h, v.shape[-1])
    return o, s_fin


def hgrn2_mixer(lat, ctx, lb_fwd, lb_bwd, norm_g, need_ctx):
    def prep(q, i, f_fwd, f_bwd, g):
        b, n, _ = q.shape
        heads = lambda t: t.reshape(b, n, HGRN_HEADS, -1).astype(F32)
        return (jax.nn.silu(heads(q)), heads(i), _hgrn_gates(heads(f_fwd), lb_fwd),
                _hgrn_gates(heads(f_bwd), lb_bwd), g)

    q_l, i_l, (kf_l, lf_l), (kb_l, lb_l), g_l = prep(*lat)
    q_c, i_c, (kf_c, lf_c), (kb_c, lb_c), g_c = prep(*ctx)
    s0 = jnp.zeros((q_l.shape[0], HGRN_HEADS, HGRN_K, HGRN_V), F32)
    rev = lambda t: jnp.flip(t, axis=1)
    o_cf, s_cf = _hgrn2_chunkwise(q_c, kf_c, i_c, lf_c, s0)
    o_lf, _ = _hgrn2_chunkwise(q_l, kf_l, i_l, lf_l, s_cf)
    o_cb, s_cb = _hgrn2_chunkwise(rev(q_c), rev(kb_c), rev(i_c), rev(lb_c), s0)
    o_lb, _ = _hgrn2_chunkwise(rev(q_l), rev(kb_l), rev(i_l), rev(lb_l), s_cb)

    def post(o, g):
        b, n = o.shape[:2]
        o = rmsnorm(o, norm_g).reshape(b, n, HGRN_WIDTH)
        return (o * jax.nn.silu(g.astype(F32))).astype(g.dtype)

    out_l = post(o_lf + rev(o_lb), g_l)
    out_c = post(o_cf + rev(o_cb), g_c) if need_ctx else None
    return out_l, out_c


def _sink_softmax(logits, sink):
    m = jnp.maximum(jnp.max(logits, axis=-1, keepdims=True), sink)
    e = jnp.exp(logits - m)
    return e / (jnp.sum(e, axis=-1, keepdims=True) + jnp.exp(sink - m))


def swa_mixer(lat, ctx, row, col, qk_g, sink, need_ctx):
    def prep(q, k, v, rotary):
        b, n, _ = q.shape
        q = rmsnorm(q.reshape(b, n, SWA_Q_HEADS, SWA_HEAD_DIM), qk_g[0])
        k = rmsnorm(k.reshape(b, n, SWA_KV_HEADS, SWA_HEAD_DIM), qk_g[1])
        if rotary:
            q, k = axial_rope(q, row, col), axial_rope(k, row, col)
        return q.reshape(b, n, SWA_KV_HEADS, SWA_GROUP, SWA_HEAD_DIM), k, v.reshape(b, n, SWA_KV_HEADS, SWA_HEAD_DIM)

    q_l, k_l, v_l = prep(*lat, True)
    q_c, k_c, v_c = prep(*ctx, False)
    scale = SWA_HEAD_DIM ** -0.5
    sink_b = sink.astype(F32).reshape(1, SWA_KV_HEADS, SWA_GROUP, 1, 1)
    b, n_lat = q_l.shape[:2]
    n_ctx = k_c.shape[1]
    span = Q_BLOCK + 2 * WINDOW
    pad = ((0, 0), (WINDOW, WINDOW), (0, 0), (0, 0))
    kp, vp = jnp.pad(k_l, pad), jnp.pad(v_l, pad)

    def block(qb, i):
        start = i * Q_BLOCK
        kw = lax.dynamic_slice_in_dim(kp, start, span, axis=1)
        vw = lax.dynamic_slice_in_dim(vp, start, span, axis=1)
        s_w = jnp.einsum('bqhgd,bkhd->bhgqk', qb, kw, preferred_element_type=F32) * scale
        qpos = start + jnp.arange(Q_BLOCK)
        kpos = start - WINDOW + jnp.arange(span)
        valid = (jnp.abs(qpos[:, None] - kpos[None, :]) <= WINDOW) & (kpos[None, :] >= 0) & (kpos[None, :] < n_lat)
        s_w = jnp.where(valid, s_w, -jnp.inf)
        s_c = jnp.einsum('bqhgd,bkhd->bhgqk', qb, k_c, preferred_element_type=F32) * scale
        p = _sink_softmax(jnp.concatenate([s_c, s_w], axis=-1), sink_b).astype(v_l.dtype)
        return (jnp.einsum('bhgqk,bkhd->bqhgd', p[..., :n_ctx], v_c)
                + jnp.einsum('bhgqk,bkhd->bqhgd', p[..., n_ctx:], vw))

    o_l = map_query_blocks(block, q_l).reshape(b, n_lat, SWA_WIDTH)
    o_c = None
    if need_ctx:
        s = jnp.einsum('bqhgd,bkhd->bhgqk', q_c, k_c, preferred_element_type=F32) * scale
        p = _sink_softmax(s, sink_b).astype(v_c.dtype)
        o_c = jnp.einsum('bhgqk,bkhd->bqhgd', p, v_c).reshape(b, n_ctx, SWA_WIDTH)
    return o_l, o_c


def swiglu(h, w1, w3, w2):
    return jnp.matmul(jax.nn.silu(jnp.matmul(h, w1)) * jnp.matmul(h, w3), w2)


def moe_swiglu(h, router, w1, w3, w2):
    logits = jnp.einsum('bld,de->ble', h, router, preferred_element_type=F32)
    top_v, top_i = lax.top_k(logits, TOP_K)
    wts = jax.nn.softmax(top_v, axis=-1)
    gates = jnp.sum(jax.nn.one_hot(top_i, N_EXPERTS, dtype=F32) * wts[..., None], axis=-2)
    y = jnp.zeros_like(h)
    for e in range(N_EXPERTS):
        y = y + gates[..., e:e + 1].astype(h.dtype) * swiglu(h, w1[e], w3[e], w2[e])
    return y


def channel_mixer(h, layer, ffn_w1, ffn_w3, ffn_w2, moe_router, moe_w1, moe_w3, moe_w2):
    j = layer // 2
    if layer % 2 == 0:
        return swiglu(h, ffn_w1[j], ffn_w3[j], ffn_w2[j])
    return moe_swiglu(h, moe_router[j], moe_w1[j], moe_w3[j], moe_w2[j])


def setup_inputs(seed: int = 0) -> dict:
    key = jax.random.key(seed)
    ks = jax.random.split(key, 24)
    nrm = lambda k, shape, s: jax.random.normal(k, shape, F32) * s
    gain = lambda k, shape: 1.0 + 0.02 * jax.random.normal(k, shape, F32)
    return {
        'x': nrm(ks[0], (BATCH, SEQ, D_MODEL), 1.0),
        'c': nrm(ks[1], (BATCH, D_MODEL), 1.0),
        'ctx': nrm(ks[2], (BATCH, CTX_LEN, D_MODEL), 1.0),
        'c_ctx': nrm(ks[3], (D_MODEL,), 1.0),
        'ada_w': nrm(ks[4], (DEPTH, D_MODEL, 6 * D_MODEL), 0.5 * D_MODEL ** -0.5),
        'ada_b': nrm(ks[5], (DEPTH, 6 * D_MODEL), 0.02),
        'norm_mix_g': gain(ks[6], (DEPTH, D_MODEL)),
        'norm_ffn_g': gain(ks[7], (DEPTH, D_MODEL)),
        'w_in': nrm(ks[8], (DEPTH, D_MODEL, D_IN), D_MODEL ** -0.5),
        'w_out': nrm(ks[9], (DEPTH, D_MIX, D_MODEL), D_MIX ** -0.5),
        'diff_qk_norm_g': gain(ks[10], (DEPTH, 2, DIFF_HEAD_DIM)),
        'diff_lambda': nrm(ks[11], (DEPTH, 4, DIFF_HEAD_DIM), 0.1),
        'diff_subln_g': gain(ks[12], (DEPTH, DIFF_V_DIM)),
        'hgrn_lb_logits': nrm(ks[13], (2, DEPTH, HGRN_WIDTH), 0.5),
        'hgrn_norm_g': gain(ks[14], (DEPTH, HGRN_V)),
        'swa_qk_norm_g': gain(ks[15], (DEPTH, 2, SWA_HEAD_DIM)),
        'swa_sink': nrm(ks[16], (DEPTH, SWA_Q_HEADS), 0.5),
        'ffn_w1': nrm(ks[17], (N_DENSE, D_MODEL, D_FF), D_MODEL ** -0.5),
        'ffn_w3': nrm(ks[18], (N_DENSE, D_MODEL, D_FF), D_MODEL ** -0.5),
        'ffn_w2': nrm(ks[19], (N_DENSE, D_FF, D_MODEL), D_FF ** -0.5),
        'moe_router': nrm(ks[20], (N_MOE, D_MODEL, N_EXPERTS), D_MODEL ** -0.5),
        'moe_w1': nrm(ks[21], (N_MOE, N_EXPERTS, D_MODEL, D_FF), D_MODEL ** -0.5),
        'moe_w3': nrm(ks[22], (N_MOE, N_EXPERTS, D_MODEL, D_FF), D_MODEL ** -0.5),
        'moe_w2': nrm(ks[23], (N_MOE, N_EXPERTS, D_FF, D_MODEL), D_FF ** -0.5),
    }


def reference(x, c, ctx, c_ctx, ada_w, ada_b, norm_mix_g, norm_ffn_g, w_in, w_out,
              diff_qk_norm_g, diff_lambda, diff_subln_g, hgrn_lb_logits, hgrn_norm_g,
              swa_qk_norm_g, swa_sink, ffn_w1, ffn_w3, ffn_w2, moe_router, moe_w1, moe_w3, moe_w2):
    row, col = grid_positions(x.shape[1])
    lb = jnp.cumsum(jax.nn.softmax(hgrn_lb_logits.astype(F32), axis=1), axis=1)
    lb = lb - lb[:, :1]
    silu_c = jax.nn.silu(c)
    silu_cc = jax.nn.silu(c_ctx)
    for layer in range(DEPTH):
        need_ctx = layer < DEPTH - 1
        m_l = [m[:, None, :] for m in jnp.split(silu_c @ ada_w[layer] + ada_b[layer], 6, axis=-1)]
        m_c = jnp.split(silu_cc @ ada_w[layer] + ada_b[layer], 6, axis=-1)
        h_l = rmsnorm(x, norm_mix_g[layer]) * (1 + m_l[1]) + m_l[0]
        h_c = rmsnorm(ctx, norm_mix_g[layer]) * (1 + m_c[1]) + m_c[0]
        p_l = split_projection(h_l, w_in[layer])
        p_c = split_projection(h_c, w_in[layer])
        lam_init = 0.8 - 0.6 * math.exp(-0.3 * layer)
        a_l, a_c = diff_attention_mixer(tuple(p_l[0:3]), tuple(p_c[0:3]), row, col, diff_qk_norm_g[layer],
                                        diff_lambda[layer], lam_init, diff_subln_g[layer], need_ctx)
        b_l, b_c = hgrn2_mixer(tuple(p_l[3:8]), tuple(p_c[3:8]), lb[0, layer], lb[1, layer],
                               hgrn_norm_g[layer], need_ctx)
        c_l, c_c = swa_mixer(tuple(p_l[8:11]), tuple(p_c[8:11]), row, col, swa_qk_norm_g[layer],
                             swa_sink[layer], need_ctx)
        x = x + m_l[2] * (jnp.concatenate([a_l, b_l, c_l], axis=-1) @ w_out[layer])
        if need_ctx:
            ctx = ctx + m_c[2] * (jnp.concatenate([a_c, b_c, c_c], axis=-1) @ w_out[layer])
        h2 = rmsnorm(x, norm_ffn_g[layer]) * (1 + m_l[4]) + m_l[3]
        x = x + m_l[5] * channel_mixer(h2, layer, ffn_w1, ffn_w3, ffn_w2, moe_router, moe_w1, moe_w3, moe_w2)
        if need_ctx:
            h2c = rmsnorm(ctx, norm_ffn_g[layer]) * (1 + m_c[4]) + m_c[3]
            ctx = ctx + m_c[5] * channel_mixer(h2c, layer, ffn_w1, ffn_w3, ffn_w2, moe_router, moe_w1, moe_w3, moe_w2)
    return x
```

```cpp
#include <hip/hip_runtime.h>
#include <cstdio>
#include <cstdint>
namespace pg8 {
#define PG8_LAS __attribute__((address_space(3)))
#define PG8_GAS __attribute__((address_space(1)))
typedef unsigned short bf16_t;
typedef short bf16x8 __attribute__((ext_vector_type(8)));
typedef float f32x4 __attribute__((ext_vector_type(4)));
typedef unsigned u32x4 __attribute__((ext_vector_type(4)));
constexpr int BM = 256, BK = 64, HALF = 128, HTB = HALF * BK * 2  , STAGE_BYTES = 8 * HTB, NXCD = 8, WGM = 8;

__host__ __device__ __forceinline__ int lds_byte(int r, int c) { const int st = (r >> 4) * 2 + (c >> 5), rr = r & 15, cc = c & 31, ob = rr * 64 + cc * 2; return st * 1024 + (ob ^ (((ob >> 9) & 1) << 5)); }
__host__ __device__ __forceinline__ void stage_rc(int b, int& R, int& C) { const int st = b / 1024, sb = b % 1024, swz = sb ^ (((sb >> 9) & 1) << 5); R = (st >> 1) * 16 + swz / 64; C = (st & 1) * 32 + (swz % 64) / 2; }
__host__ __device__ __forceinline__ int perm32(int rho) { const int n = rho >> 4, i = rho & 15; return 8 * (i >> 2) + 4 * n + (i & 3); }

struct Unit { int pm, pn; };
struct Gemm { const bf16_t* A; const bf16_t* Bt; int M, N, K; };

struct StaticOrder {
    int nM, nN, nwg, G, c, wgm;
    __host__ __device__ void init(int M, int N, int G_, int c_, int wgm_ = WGM) { nM = M / BM; nN = N / BM; nwg = nM * nN; G = G_; c = c_; wgm = wgm_; }
    __host__ __device__ bool next(int i, Unit& u) const {
        const long L = (long)i * G + c; if (L >= nwg) return false;
        int wgid = (int)L; { const int q = nwg / NXCD, r = nwg % NXCD, xcd = wgid % NXCD, off = wgid / NXCD; wgid = (xcd < r ? xcd * (q + 1) : r * (q + 1) + (xcd - r) * q) + off; }
        const int nig = wgm * nN, gid = wgid / nig, fm = gid * wgm, gsz = (nM - fm) < wgm ? (nM - fm) : wgm;
        u.pm = fm + ((wgid % nig) % gsz); u.pn = (wgid % nig) / gsz; return true;
    }
    __device__ __forceinline__ void a_ready(const Unit&) const {}
    __device__ __forceinline__ void done(const Unit&) const {}
    __device__ __forceinline__ size_t boff(const Unit&) const { return 0; }
    static constexpr bool GATHER = false;
    __device__ __forceinline__ const int* rowidx() const { return nullptr; }
};
struct GroupedOrder : StaticOrder {
    const volatile PG8_LAS int* segt; size_t estride;
    __device__ __forceinline__ size_t boff(const Unit& u) const { int e = 0;
#pragma unroll
        for (int k = 1; k < 8; ++k) e += (u.pm >= __builtin_amdgcn_readfirstlane(segt[k])) ? 1 : 0;
        return (size_t)e * estride; }
};
struct GatherOrder : GroupedOrder {
    const int* tok;
    static constexpr bool GATHER = true;
    __device__ __forceinline__ const int* rowidx() const { return tok; }
};

__device__ __forceinline__ unsigned cvt_pk_bf16(float lo, float hi) { unsigned r; asm volatile("v_cvt_pk_bf16_f32 %0, %1, %2" : "=v"(r) : "v"(lo), "v"(hi)); return r; }
__device__ __forceinline__ float silu_f(float a) { return a * __builtin_amdgcn_rcpf(1.f + __expf(-a)); }
__device__ __forceinline__ float dn_rstd(const float* ssp, int row) { const f32x4 a = *(const PG8_GAS f32x4*)(ssp + (size_t)row * 4); return __builtin_amdgcn_rsqf(((a[0] + a[1]) + (a[2] + a[3])) * (1.f / 1024.f) + 1e-6f); }
struct EpiStoreBf16 {
    static constexpr bool PERM = true, AFTER_DRAIN = false;
    bf16_t* O; int ldc; const float* ssp; const float* bias; const float* dqk; const float* sqk; int lane;
    __device__ __forceinline__ void operator()(const f32x4 (&acc)[2][2][4][2], const Unit& u, int wr, int wc, int fr, int fq) const {
        const int row0 = u.pm * BM + wr * 64 + fr, col0 = u.pn * BM + wc * 32 + 8 * fq;
        f32x4 bv[2][2];
        if (ssp) { const float* bp = bias + (size_t)(u.pm < 256 ? (u.pm >> 3) : 32) * ldc + col0;
#pragma unroll
            for (int bj = 0; bj < 2; ++bj) { bv[bj][0] = *(const PG8_GAS f32x4*)(bp + bj * HALF); bv[bj][1] = *(const PG8_GAS f32x4*)(bp + bj * HALF + 4); } }
        float rsv[2][4];
#pragma unroll
        for (int ai = 0; ai < 2; ++ai)
#pragma unroll
            for (int m = 0; m < 4; ++m) rsv[ai][m] = 1.f;
        if (ssp) { f32x4 sv[2][4];
#pragma unroll
            for (int ai = 0; ai < 2; ++ai)
#pragma unroll
                for (int m = 0; m < 4; ++m) sv[ai][m] = *(const PG8_GAS f32x4*)(ssp + (size_t)(row0 + ai * HALF + m * 16) * 4);
#pragma unroll
            for (int ai = 0; ai < 2; ++ai)
#pragma unroll
                for (int m = 0; m < 4; ++m) rsv[ai][m] = __builtin_amdgcn_rsqf(((sv[ai][m][0] + sv[ai][m][1]) + (sv[ai][m][2] + sv[ai][m][3])) * (1.f / 1024.f) + 1e-6f); }
#define PG8_RS(ai_, m_) rsv[ai_][m_]
        const bool tileA = u.pn < 2, tileC = u.pn >= 13, qk = tileA || (tileC && (u.pn == 13 || wc < 2));
        if (!tileA && !tileC) {
            const bool hq = (u.pn == 3) || (u.pn == 4);
#pragma unroll
            for (int ai = 0; ai < 2; ++ai)
#pragma unroll
                for (int m = 0; m < 4; ++m) { const int row = row0 + ai * HALF + m * 16; bf16_t* rowp = O + (size_t)row * ldc + u.pn * BM + 64 * wc + 8 * fq;
                    const float rs = PG8_RS(ai, m);
#pragma unroll
                    for (int bj = 0; bj < 2; ++bj) { f32x4 v0 = acc[ai][bj][m][0], v1 = acc[ai][bj][m][1];
                        if (ssp) { v0 = v0 * rs + bv[bj][0]; v1 = v1 * rs + bv[bj][1]; }
                        if (hq) { v0[0] = silu_f(v0[0]); v0[1] = silu_f(v0[1]); v0[2] = silu_f(v0[2]); v0[3] = silu_f(v0[3]); v1[0] = silu_f(v1[0]); v1[1] = silu_f(v1[1]); v1[2] = silu_f(v1[2]); v1[3] = silu_f(v1[3]); }
                        u32x4 o; o.x = cvt_pk_bf16(v0[0], v0[1]); o.y = cvt_pk_bf16(v0[2], v0[3]); o.z = cvt_pk_bf16(v1[0], v1[1]); o.w = cvt_pk_bf16(v1[2], v1[3]);
                        *(PG8_GAS u32x4*)(rowp + bj * 32) = o; } }
            return; }
        const bool lat = u.pm < 256;
        float gn[2][2][4], inv[4];
        const float scale = (u.pn == 0) ? 0.25503486f : (u.pn == 13 ? 0.18033688f : 1.f);
        if (tileA) { const float* g = dqk + u.pn * 32 + ((fq >> 1) * 16 + (fq & 1) * 4);
#pragma unroll
            for (int n = 0; n < 2; ++n)
#pragma unroll
                for (int j = 0; j < 4; ++j) { const float gv = *(const PG8_GAS float*)(g + 8 * n + j); gn[0][n][j] = gv; gn[1][n][j] = gv; }
#pragma unroll
            for (int j = 0; j < 4; ++j) inv[j] = __builtin_amdgcn_exp2f(-(float)(4 * (fq & 1) + j) * (13.287712379549449f / 8.f)); }
        else { const float* g = sqk + (u.pn == 13 ? 0 : 64) + 4 * fq;
#pragma unroll
            for (int bj = 0; bj < 2; ++bj)
#pragma unroll
                for (int n = 0; n < 2; ++n)
#pragma unroll
                    for (int j = 0; j < 4; ++j) gn[bj][n][j] = qk ? *(const PG8_GAS float*)(g + 32 * bj + 16 * n + j) : 1.f;
#pragma unroll
            for (int j = 0; j < 4; ++j) inv[j] = __builtin_amdgcn_exp2f(-(float)(4 * fq + j) * (13.287712379549449f / 16.f)); }
        int scol[2][2];
#pragma unroll
        for (int bj = 0; bj < 2; ++bj)
#pragma unroll
            for (int n = 0; n < 2; ++n) scol[bj][n] = tileA ? u.pn * BM + (4 * bj + wc) * 32 + (fq >> 1) * 16 + (fq & 1) * 4 + 8 * n : u.pn * BM + 64 * wc + 32 * bj + 16 * n + 4 * fq;
#pragma unroll
        for (int ai = 0; ai < 2; ++ai)
#pragma unroll
            for (int m = 0; m < 4; ++m) { const int row = row0 + ai * HALF + m * 16; bf16_t* rowp = O + (size_t)row * ldc;
                const float rs = PG8_RS(ai, m);
                f32x4 v[2][2];
#pragma unroll
                for (int bj = 0; bj < 2; ++bj)
#pragma unroll
                    for (int n = 0; n < 2; ++n) { v[bj][n] = acc[ai][bj][m][n]; if (ssp) v[bj][n] = v[bj][n] * rs + bv[bj][n]; }
                if (qk) {
                    float s0 = 0.f, s1 = 0.f;
#pragma unroll
                    for (int n = 0; n < 2; ++n) { s0 += (v[0][n][0] * v[0][n][0] + v[0][n][1] * v[0][n][1]) + (v[0][n][2] * v[0][n][2] + v[0][n][3] * v[0][n][3]); s1 += (v[1][n][0] * v[1][n][0] + v[1][n][1] * v[1][n][1]) + (v[1][n][2] * v[1][n][2] + v[1][n][3] * v[1][n][3]); }
                    if (!tileA) { s0 += s1; s1 = s0; }
                    s0 += __builtin_bit_cast(float, __builtin_amdgcn_ds_bpermute((lane ^ 16) << 2, __builtin_bit_cast(int, s0))); s0 += __builtin_bit_cast(float, __builtin_amdgcn_ds_bpermute((lane ^ 32) << 2, __builtin_bit_cast(int, s0)));
                    if (tileA) { s1 += __builtin_bit_cast(float, __builtin_amdgcn_ds_bpermute((lane ^ 16) << 2, __builtin_bit_cast(int, s1))); s1 += __builtin_bit_cast(float, __builtin_amdgcn_ds_bpermute((lane ^ 32) << 2, __builtin_bit_cast(int, s1))); } else s1 = s0;
                    const float nd = tileA ? (1.f / 32.f) : (1.f / 64.f);
                    const float r0 = __builtin_amdgcn_rsqf(s0 * nd + 1e-6f), r1 = __builtin_amdgcn_rsqf(s1 * nd + 1e-6f);
#pragma unroll
                    for (int n = 0; n < 2; ++n)
#pragma unroll
                        for (int j = 0; j < 4; ++j) { v[0][n][j] = v[0][n][j] * r0 * gn[0][n][j]; v[1][n][j] = v[1][n][j] * r1 * gn[1][n][j]; }
                    if (lat) { const int t = row & 2047; const float prow = (float)(t >> 6), pcol = (float)(t & 63);
#pragma unroll
                        for (int bj = 0; bj < 2; ++bj) { const float pos = tileA ? (fq < 2 ? prow : pcol) : (bj ? pcol : prow);
#pragma unroll
                            for (int j = 0; j < 4; ++j) { const float a = pos * inv[j], cs = __cosf(a), sn = __sinf(a), x1 = v[bj][0][j], x2 = v[bj][1][j]; v[bj][0][j] = x1 * cs - x2 * sn; v[bj][1][j] = x1 * sn + x2 * cs; } } }
#pragma unroll
                    for (int bj = 0; bj < 2; ++bj)
#pragma unroll
                        for (int n = 0; n < 2; ++n) v[bj][n] = v[bj][n] * scale;
                }
#pragma unroll
                for (int bj = 0; bj < 2; ++bj)
#pragma unroll
                    for (int n = 0; n < 2; ++n) { const unsigned lo = cvt_pk_bf16(v[bj][n][0], v[bj][n][1]), hi = cvt_pk_bf16(v[bj][n][2], v[bj][n][3]);
                        *(PG8_GAS unsigned long long*)(rowp + scol[bj][n]) = (unsigned long long)lo | ((unsigned long long)hi << 32); } }
    }
};
struct EpiSwiglu {
    static constexpr bool PERM = true, AFTER_DRAIN = false;
    bf16_t* O; int ldc; const float* ssp; const float* bias1; const float* bias3;
    __device__ __forceinline__ void operator()(const f32x4 (&acc)[2][2][4][2], const Unit& u, int wr, int wc, int fr, int fq) const {
        const int row0 = u.pm * BM + wr * 64 + fr, col0 = u.pn * HALF + wc * 32 + 8 * fq;
        f32x4 b1[2], b3[2];
        if (ssp) { const size_t bo = (size_t)(u.pm < 256 ? (u.pm >> 3) : 32) * ldc + col0;
            b1[0] = *(const PG8_GAS f32x4*)(bias1 + bo); b1[1] = *(const PG8_GAS f32x4*)(bias1 + bo + 4); b3[0] = *(const PG8_GAS f32x4*)(bias3 + bo); b3[1] = *(const PG8_GAS f32x4*)(bias3 + bo + 4); }
        float rsv[2][4];
        if (ssp) { f32x4 sv[2][4];
#pragma unroll
            for (int ai = 0; ai < 2; ++ai)
#pragma unroll
                for (int m = 0; m < 4; ++m) sv[ai][m] = *(const PG8_GAS f32x4*)(ssp + (size_t)(row0 + ai * HALF + m * 16) * 4);
#pragma unroll
            for (int ai = 0; ai < 2; ++ai)
#pragma unroll
                for (int m = 0; m < 4; ++m) rsv[ai][m] = __builtin_amdgcn_rsqf(((sv[ai][m][0] + sv[ai][m][1]) + (sv[ai][m][2] + sv[ai][m][3])) * (1.f / 1024.f) + 1e-6f); }
#pragma unroll
        for (int ai = 0; ai < 2; ++ai)
#pragma unroll
            for (int m = 0; m < 4; ++m) { const int row = row0 + ai * HALF + m * 16; bf16_t* rowp = O + (size_t)row * ldc + col0;
                f32x4 a0 = acc[ai][0][m][0], a1 = acc[ai][0][m][1], c0 = acc[ai][1][m][0], c1 = acc[ai][1][m][1];
                if (ssp) { const float rs = rsv[ai][m]; a0 = a0 * rs + b1[0]; a1 = a1 * rs + b1[1]; c0 = c0 * rs + b3[0]; c1 = c1 * rs + b3[1]; }
                u32x4 o; o.x = cvt_pk_bf16(silu_f(a0[0]) * c0[0], silu_f(a0[1]) * c0[1]); o.y = cvt_pk_bf16(silu_f(a0[2]) * c0[2], silu_f(a0[3]) * c0[3]);
                o.z = cvt_pk_bf16(silu_f(a1[0]) * c1[0], silu_f(a1[1]) * c1[1]); o.w = cvt_pk_bf16(silu_f(a1[2]) * c1[2], silu_f(a1[3]) * c1[3]);
                *(PG8_GAS u32x4*)rowp = o; }
    }
};
__device__ __forceinline__ void bf8_unpack(const u32x4 u, f32x4& a, f32x4& b) {
    a[0] = __builtin_bit_cast(float, u.x << 16); a[1] = __builtin_bit_cast(float, u.x & 0xffff0000u); a[2] = __builtin_bit_cast(float, u.y << 16); a[3] = __builtin_bit_cast(float, u.y & 0xffff0000u);
    b[0] = __builtin_bit_cast(float, u.z << 16); b[1] = __builtin_bit_cast(float, u.z & 0xffff0000u); b[2] = __builtin_bit_cast(float, u.w << 16); b[3] = __builtin_bit_cast(float, u.w & 0xffff0000u); }
__device__ __forceinline__ u32x4 bf8_pack(const f32x4& a, const f32x4& b) { u32x4 o; o.x = cvt_pk_bf16(a[0], a[1]); o.y = cvt_pk_bf16(a[2], a[3]); o.z = cvt_pk_bf16(b[0], b[1]); o.w = cvt_pk_bf16(b[2], b[3]); return o; }
struct EpiRes {
    static constexpr bool PERM = true, AFTER_DRAIN = false;
    const bf16_t* xin_l; bf16_t* xout_l; const bf16_t* xin_c; bf16_t* xout_c; const float* mod; bf16_t* nx; const float* gsc; float* ssp; int lane; PG8_LAS float* red;
    __device__ __forceinline__ void operator()(const f32x4 (&acc)[2][2][4][2], const Unit& u, int wr, int wc, int fr, int fq) const {
        const bool lat = u.pm < 256;
        const int rloc = (lat ? u.pm : u.pm - 256) * BM + wr * 64 + fr, col0 = u.pn * BM + wc * 32 + 8 * fq, bsel = lat ? (u.pm >> 3) : 32;
        const bf16_t* xin = lat ? xin_l : xin_c; bf16_t* xout = lat ? xout_l : xout_c;
        const float* md = mod + (size_t)bsel * 6144 + col0;
        f32x4 mv[2][2], gv[2][2];
#pragma unroll
        for (int bj = 0; bj < 2; ++bj)
#pragma unroll
            for (int n = 0; n < 2; ++n) { mv[bj][n] = *(const PG8_GAS f32x4*)(md + bj * HALF + n * 4); if (nx) gv[bj][n] = *(const PG8_GAS f32x4*)(gsc + (size_t)bsel * 1024 + col0 + bj * HALF + n * 4); }
#pragma unroll
        for (int ai = 0; ai < 2; ++ai) {
            u32x4 xv[4][2];
#pragma unroll
            for (int m = 0; m < 4; ++m)
#pragma unroll
                for (int bj = 0; bj < 2; ++bj) xv[m][bj] = *(const PG8_GAS u32x4*)(xin + (size_t)(rloc + ai * HALF + m * 16) * 1024 + col0 + bj * HALF);
#pragma unroll
            for (int m = 0; m < 4; ++m) { const size_t p = (size_t)(rloc + ai * HALF + m * 16) * 1024 + col0; const int urow = u.pm * BM + wr * 64 + fr + ai * HALF + m * 16;
                float ss = 0.f;
#pragma unroll
                for (int bj = 0; bj < 2; ++bj) { f32x4 x0, x1; bf8_unpack(xv[m][bj], x0, x1);
                    const f32x4 y0 = x0 + mv[bj][0] * acc[ai][bj][m][0], y1 = x1 + mv[bj][1] * acc[ai][bj][m][1];
                    *(PG8_GAS u32x4*)(xout + p + bj * HALF) = bf8_pack(y0, y1);
                    if (nx) { ss += ((y0[0] * y0[0] + y0[1] * y0[1]) + (y0[2] * y0[2] + y0[3] * y0[3])) + ((y1[0] * y1[0] + y1[1] * y1[1]) + (y1[2] * y1[2] + y1[3] * y1[3]));
                        *(PG8_GAS u32x4*)(nx + (size_t)urow * 1024 + col0 + bj * HALF) = bf8_pack(y0 * gv[bj][0], y1 * gv[bj][1]); } }
                if (nx) { ss += __builtin_bit_cast(float, __builtin_amdgcn_ds_bpermute((lane ^ 16) << 2, __builtin_bit_cast(int, ss))); ss += __builtin_bit_cast(float, __builtin_amdgcn_ds_bpermute((lane ^ 32) << 2, __builtin_bit_cast(int, ss)));
                    if (fq == 0) red[(wr * 64 + fr + ai * HALF + m * 16) * 4 + wc] = ss; } } }
        if (nx) { asm volatile("s_waitcnt lgkmcnt(0)" ::: "memory"); __builtin_amdgcn_s_barrier(); asm volatile("" ::: "memory");
            if (wc == 0 && fq == 0) {
#pragma unroll
                for (int ai = 0; ai < 2; ++ai)
#pragma unroll
                    for (int m = 0; m < 4; ++m) { const int rr = wr * 64 + fr + ai * HALF + m * 16; const f32x4 v = *(const PG8_LAS f32x4*)(red + rr * 4);
                        *(PG8_GAS float*)(ssp + (size_t)(u.pm * BM + rr) * 4 + u.pn) = (v[0] + v[1]) + (v[2] + v[3]); } }
            asm volatile("s_waitcnt lgkmcnt(0)" ::: "memory"); __builtin_amdgcn_s_barrier(); asm volatile("" ::: "memory"); }
    }
};
struct EpiMoeRes {
    static constexpr bool PERM = true, AFTER_DRAIN = false;
    bf16_t* x_l; bf16_t* x_c; const float* mod; const int* tok; const float* wgt; bf16_t* nx; const float* gsc; float* ssp; int lane; PG8_LAS float* red; bf16_t* y0w; const bf16_t* y0r; float* xfinal;
    __device__ __forceinline__ void operator()(const f32x4 (&acc)[2][2][4][2], const Unit& u, int wr, int wc, int fr, int fq) const {
        const int col0 = u.pn * BM + wc * 32 + 8 * fq;
        int tkv[2][4]; float wvv[2][4];
#pragma unroll
        for (int ai = 0; ai < 2; ++ai)
#pragma unroll
            for (int m = 0; m < 4; ++m) { const int pos = u.pm * BM + wr * 64 + fr + ai * HALF + m * 16; tkv[ai][m] = *(const PG8_GAS int*)(tok + pos); wvv[ai][m] = *(const PG8_GAS float*)(wgt + pos); }
        u32x4 xn[2], yn[2];
        xn[0] = xn[1] = yn[0] = yn[1] = (u32x4){0u, 0u, 0u, 0u};
#define MR_LOADXY(k_) do { const int t_ = tkv[(k_) >> 2][(k_) & 3]; if (!y0w && t_ >= 0) { const bf16_t* xp_ = ((t_ < 65536) ? x_l + (size_t)t_ * 1024 : x_c + (size_t)(t_ - 65536) * 1024) + col0; \
            _Pragma("unroll") for (int bj_ = 0; bj_ < 2; ++bj_) { xn[bj_] = *(const PG8_GAS u32x4*)(xp_ + bj_ * HALF); yn[bj_] = *(const PG8_GAS u32x4*)(y0r + (size_t)t_ * 1024 + col0 + bj_ * HALF); } } } while (0)
        MR_LOADXY(0);
#pragma unroll
        for (int k = 0; k < 8; ++k) { const int ai = k >> 2, m = k & 3; const int t = tkv[ai][m]; float ss = 0.f;
                const u32x4 xc[2] = {xn[0], xn[1]}, yc[2] = {yn[0], yn[1]};
                if (k + 1 < 8) MR_LOADXY(k + 1);
                if (t >= 0) { const float w = wvv[ai][m]; const bool lat = t < 65536; const int bsel = lat ? (t >> 11) : 32;
                    bf16_t* xp = (lat ? x_l + (size_t)t * 1024 : x_c + (size_t)(t - 65536) * 1024) + col0; const float* md = mod + (size_t)bsel * 6144 + col0;
#pragma unroll
                    for (int bj = 0; bj < 2; ++bj) { const f32x4 m0 = *(const PG8_GAS f32x4*)(md + bj * HALF), m1 = *(const PG8_GAS f32x4*)(md + bj * HALF + 4);
                        const f32x4 d0 = m0 * acc[ai][bj][m][0] * w, d1 = m1 * acc[ai][bj][m][1] * w;
                        if (y0w) { u32x4 o; o.x = cvt_pk_bf16(d0[0], d0[1]); o.y = cvt_pk_bf16(d0[2], d0[3]); o.z = cvt_pk_bf16(d1[0], d1[1]); o.w = cvt_pk_bf16(d1[2], d1[3]);
                            *(PG8_GAS u32x4*)(y0w + (size_t)t * 1024 + col0 + bj * HALF) = o; }
                        else { f32x4 x0, x1; bf8_unpack(xc[bj], x0, x1); const u32x4 yv = yc[bj];
                            f32x4 e0, e1; e0[0] = __builtin_bit_cast(float, yv.x << 16); e0[1] = __builtin_bit_cast(float, yv.x & 0xffff0000u); e0[2] = __builtin_bit_cast(float, yv.y << 16); e0[3] = __builtin_bit_cast(float, yv.y & 0xffff0000u);
                            e1[0] = __builtin_bit_cast(float, yv.z << 16); e1[1] = __builtin_bit_cast(float, yv.z & 0xffff0000u); e1[2] = __builtin_bit_cast(float, yv.w << 16); e1[3] = __builtin_bit_cast(float, yv.w & 0xffff0000u);
                            const f32x4 y0 = x0 + (e0 + d0), y1 = x1 + (e1 + d1);
                            if (xfinal) { float* fp = xfinal + (size_t)t * 1024 + col0 + bj * HALF; *(PG8_GAS f32x4*)fp = y0; *(PG8_GAS f32x4*)(fp + 4) = y1; } else *(PG8_GAS u32x4*)(xp + bj * HALF) = bf8_pack(y0, y1);
                            if (nx) { ss += ((y0[0] * y0[0] + y0[1] * y0[1]) + (y0[2] * y0[2] + y0[3] * y0[3])) + ((y1[0] * y1[0] + y1[1] * y1[1]) + (y1[2] * y1[2] + y1[3] * y1[3]));
                                const float* gp = gsc + (size_t)bsel * 1024 + col0 + bj * HALF; const f32x4 z0 = y0 * *(const PG8_GAS f32x4*)gp, z1 = y1 * *(const PG8_GAS f32x4*)(gp + 4);
                                u32x4 o; o.x = cvt_pk_bf16(z0[0], z0[1]); o.y = cvt_pk_bf16(z0[2], z0[3]); o.z = cvt_pk_bf16(z1[0], z1[1]); o.w = cvt_pk_bf16(z1[2], z1[3]);
                                *(PG8_GAS u32x4*)(nx + (size_t)t * 1024 + col0 + bj * HALF) = o; } } } }
                if (nx) { ss += __builtin_bit_cast(float, __builtin_amdgcn_ds_bpermute((lane ^ 16) << 2, __builtin_bit_cast(int, ss))); ss += __builtin_bit_cast(float, __builtin_amdgcn_ds_bpermute((lane ^ 32) << 2, __builtin_bit_cast(int, ss)));
                    if (fq == 0) red[(wr * 64 + fr + ai * HALF + m * 16) * 4 + wc] = ss; } }
        if (nx) { asm volatile("s_waitcnt lgkmcnt(0)" ::: "memory"); __builtin_amdgcn_s_barrier(); asm volatile("" ::: "memory");
            if (wc == 0 && fq == 0) {
#pragma unroll
                for (int ai = 0; ai < 2; ++ai)
#pragma unroll
                    for (int m = 0; m < 4; ++m) { const int rr = wr * 64 + fr + ai * HALF + m * 16; const int t = *(const PG8_GAS int*)(tok + u.pm * BM + rr); const f32x4 v = *(const PG8_LAS f32x4*)(red + rr * 4);
                        if (t >= 0) *(PG8_GAS float*)(ssp + (size_t)t * 4 + u.pn) = (v[0] + v[1]) + (v[2] + v[3]); } }
            asm volatile("s_waitcnt lgkmcnt(0)" ::: "memory"); __builtin_amdgcn_s_barrier(); asm volatile("" ::: "memory"); }
    }
};
struct EpiBias {
    static constexpr bool PERM = false, AFTER_DRAIN = false;
    float* out; float* out3; int ldo; int split;
    __device__ __forceinline__ void operator()(const f32x4 (&acc)[2][2][4][2], const Unit& u, int wr, int wc, int fr, int fq) const {
        if (wr != 0) return;
#pragma unroll
        for (int m = 0; m < 3; ++m) { const int row = m * 16 + fr; if (row < 33) {
#pragma unroll
            for (int bj = 0; bj < 2; ++bj)
#pragma unroll
                for (int n = 0; n < 2; ++n) { const int c = wc * 32 + n * 16 + 4 * fq;
                    if (split) *(PG8_GAS f32x4*)((bj ? out3 : out) + (size_t)row * ldo + u.pn * HALF + c) = acc[0][bj][m][n];
                    else *(PG8_GAS f32x4*)(out + (size_t)row * ldo + u.pn * BM + bj * HALF + c) = acc[0][bj][m][n]; } } }
    }
};
template <class Epi, class Sched, bool ALIGN_EPI = false, bool SP2 = false>
__device__ __forceinline__ void gemm_phase(PG8_LAS unsigned char* lds, const Gemm g, const Sched& S, const Epi& E) {
    int tid = threadIdx.x; asm volatile("" : "+v"(tid));
    const int wid = __builtin_amdgcn_readfirstlane(tid >> 6), lane = tid & 63, wr = wid >> 2, wc = wid & 3, fr = lane & 15, fq = lane >> 4;
    const int K = g.K, nt = K / BK;
    unsigned voffA[2], voffB[2];
#pragma unroll
    for (int i = 0; i < 2; ++i) { int R, C; stage_rc(tid * 16 + i * 8192, R, C); const int Rb = Epi::PERM ? ((R & ~31) + perm32(R & 31)) : R;
        voffA[i] = (unsigned)(R * K + C) * 2u; voffB[i] = (unsigned)(Rb * K + C) * 2u; }
    const size_t kstep = (size_t)(BK * 2);
    const size_t hstep = (size_t)HALF * K * 2;
    const size_t tstep = 2 * hstep;
    const unsigned ldsw = (unsigned)wid * 1024u;
    const int aoff = lds_byte(wr * 64 + fr, fq * 8), boff = lds_byte(wc * 32 + fr, fq * 8);
#define PG8_SA(b, h) (((b) * 2 + (h)) * HTB)
#define PG8_SB(b, h) ((4 + (b) * 2 + (h)) * HTB)
#define PG8_STAGE(bufoff, gbase, voff) do { _Pragma("unroll") for (int _i = 0; _i < 2; ++_i) \
        __builtin_amdgcn_global_load_lds((const unsigned*)((const char*)(gbase) + (voff)[_i]), (PG8_LAS unsigned*)(lds + (bufoff) + ldsw + _i * 8192), 16, 0, 0); } while (0)
#define PG8_LDA(dst, b, h) do { _Pragma("unroll") for (int m = 0; m < 4; ++m) _Pragma("unroll") for (int k = 0; k < 2; ++k) dst[m][k] = *(const PG8_LAS bf16x8*)(lds + PG8_SA(b, h) + aoff + m * 2048 + k * 1024); } while (0)
#define PG8_LDB(dst, b, h) do { _Pragma("unroll") for (int n = 0; n < 2; ++n) _Pragma("unroll") for (int k = 0; k < 2; ++k) dst[n][k] = *(const PG8_LAS bf16x8*)(lds + PG8_SB(b, h) + boff + n * 2048 + k * 1024); } while (0)
#define PG8_MMA(ai, bj, At, Bt) do { __builtin_amdgcn_s_setprio(1); _Pragma("unroll") for (int m = 0; m < 4; ++m) _Pragma("unroll") for (int n = 0; n < 2; ++n) _Pragma("unroll") for (int k = 0; k < 2; ++k) \
        acc[ai][bj][m][n] = __builtin_amdgcn_mfma_f32_16x16x32_bf16(Bt[n][k], At[m][k], acc[ai][bj][m][n], 0, 0, 0); __builtin_amdgcn_s_setprio(0); } while (0)
#define PG8_WAIT_V(n) asm volatile("s_waitcnt vmcnt(" #n ")" ::: "memory")
#define PG8_WAIT_L(n) asm volatile("s_waitcnt lgkmcnt(" #n ")" ::: "memory")
#define PG8_BAR __builtin_amdgcn_s_barrier()
#define PG8_SCHED __builtin_amdgcn_sched_barrier(0)
    Unit cur, nxt; int ui = 0;
    if (!S.next(0, cur)) return;
    f32x4 acc[2][2][4][2];
#pragma unroll
    for (int a = 0; a < 2; ++a)
#pragma unroll
        for (int b = 0; b < 2; ++b)
#pragma unroll
            for (int m = 0; m < 4; ++m)
#pragma unroll
                for (int n = 0; n < 2; ++n) acc[a][b][m][n] = (f32x4){0.f, 0.f, 0.f, 0.f};
    bf16x8 At[4][2], B0[2][2], B1[2][2];
    const char* cA = Sched::GATHER ? (const char*)g.A : (const char*)g.A + (size_t)cur.pm * tstep; const char* cB = (const char*)g.Bt + (size_t)cur.pn * tstep + S.boff(cur);
    unsigned goA[2][2]; int gR[2], gC2[2];
    PG8_LAS int* const gidx = (PG8_LAS int*)(lds + STAGE_BYTES);
    if constexpr (Sched::GATHER) {
#pragma unroll
        for (int i = 0; i < 2; ++i) { int R, C; stage_rc(tid * 16 + i * 8192, R, C); gR[i] = R; gC2[i] = 2 * C; }
#pragma unroll
        for (int h = 0; h < 2; ++h)
#pragma unroll
            for (int i = 0; i < 2; ++i) { const int t_ = *(const PG8_GAS int*)(S.rowidx() + cur.pm * BM + h * HALF + gR[i]); goA[h][i] = (unsigned)(t_ < 0 ? 0 : t_) * (unsigned)(2 * K) + (unsigned)gC2[i]; }
    }
#define PG8_GOFF(nb_, h, i) ((unsigned)(gidx[(nb_) * 256 + (h) * HALF + gR[i]] < 0 ? 0 : gidx[(nb_) * 256 + (h) * HALF + gR[i]]) * (unsigned)(2 * K) + (unsigned)gC2[i])
#define PG8_STAGE_A(bufoff, base_ng, h, kt, nextu) do { if constexpr (Sched::GATHER) { unsigned vo_[2]; \
            if (nextu) { vo_[0] = PG8_GOFF((ui + 1) & 1, h, 0); vo_[1] = PG8_GOFF((ui + 1) & 1, h, 1); } else { vo_[0] = goA[h][0]; vo_[1] = goA[h][1]; } \
            PG8_STAGE(bufoff, (const char*)g.A + (size_t)(kt) * kstep, vo_); } else { PG8_STAGE(bufoff, (base_ng) + (h) * hstep, voffA); } } while (0)
    S.a_ready(cur);
    if constexpr (SP2) {
        PG8_STAGE(PG8_SB(0, 0), cB, voffB); PG8_STAGE(PG8_SB(0, 1), cB + hstep, voffB); PG8_STAGE_A(PG8_SA(0, 0), cA, 0, 0, false); PG8_STAGE_A(PG8_SA(0, 1), cA, 1, 0, false);
        if (wr == 1) PG8_BAR;
        PG8_WAIT_V(2); PG8_BAR;
        PG8_STAGE(PG8_SB(1, 0), cB + kstep, voffB); PG8_STAGE_A(PG8_SA(1, 0), cA + kstep, 0, 1, false); PG8_STAGE(PG8_SB(1, 1), cB + hstep + kstep, voffB);
        PG8_WAIT_V(6); PG8_BAR;
    } else {
        PG8_STAGE(PG8_SB(0, 0), cB, voffB); PG8_STAGE(PG8_SA(0, 0), cA, voffA); PG8_STAGE(PG8_SB(0, 1), cB + hstep, voffB); PG8_STAGE(PG8_SA(0, 1), cA + hstep, voffA);
        if (wr == 1) PG8_BAR;
        PG8_WAIT_V(4); PG8_BAR;
        PG8_STAGE(PG8_SB(1, 0), cB + kstep, voffB); PG8_STAGE(PG8_SA(1, 0), cA + kstep, voffA); PG8_STAGE(PG8_SB(1, 1), cB + hstep + kstep, voffB);
        PG8_WAIT_V(6); PG8_BAR;
    }
    for (;;) {
        const bool has_next = S.next(ui + 1, nxt);
        const char* nA = Sched::GATHER ? cA : (has_next ? (const char*)g.A + (size_t)nxt.pm * tstep : cA); const char* nB = has_next ? (const char*)g.Bt + (size_t)nxt.pn * tstep + S.boff(nxt) : cB;
        if constexpr (Sched::GATHER) {
            const int gpm = has_next ? nxt.pm : cur.pm;
            if (wid < 4) __builtin_amdgcn_global_load_lds((const unsigned*)(S.rowidx() + gpm * BM + wid * 64 + lane), (PG8_LAS unsigned*)(gidx + ((ui + 1) & 1) * 256 + wid * 64), 4, 0, 0);
        }
        for (int t = 0; t < nt; t += 2) {
            const bool last = (t == nt - 2);
            const char* a1 = cA + (size_t)(t + 1) * kstep;
            const char* a2 = last ? nA : cA + (size_t)(t + 2) * kstep; const char* b2 = last ? nB : cB + (size_t)(t + 2) * kstep;
            const char* a3 = a2 + kstep; const char* b3 = b2 + kstep;
            if (last && has_next) S.a_ready(nxt);
            if constexpr (SP2) {
            PG8_LDB(B0, 0, 0); PG8_LDB(B1, 0, 1); PG8_SCHED; PG8_LDA(At, 0, 0); PG8_STAGE_A(PG8_SA(1, 1), a1, 1, t + 1, false);
            PG8_WAIT_V(8); PG8_WAIT_L(0); PG8_BAR; PG8_MMA(0, 0, At, B0); PG8_MMA(0, 1, At, B1); PG8_BAR; PG8_SCHED;
            PG8_LDA(At, 0, 1); PG8_STAGE(PG8_SB(0, 0), b2, voffB); PG8_STAGE(PG8_SB(0, 1), b2 + hstep, voffB); PG8_STAGE_A(PG8_SA(0, 0), a2, 0, last ? 0 : t + 2, last);
            PG8_WAIT_V(8); PG8_WAIT_L(0); PG8_BAR; PG8_MMA(1, 0, At, B0); PG8_MMA(1, 1, At, B1); PG8_BAR; PG8_SCHED;
            PG8_LDB(B0, 1, 0); PG8_LDB(B1, 1, 1); PG8_SCHED; PG8_LDA(At, 1, 0); PG8_STAGE_A(PG8_SA(0, 1), a2, 1, last ? 0 : t + 2, last);
            PG8_WAIT_V(8); PG8_WAIT_L(0); PG8_BAR; PG8_MMA(0, 0, At, B0); PG8_MMA(0, 1, At, B1); PG8_BAR; PG8_SCHED;
            PG8_LDA(At, 1, 1); PG8_STAGE(PG8_SB(1, 0), b3, voffB); PG8_STAGE(PG8_SB(1, 1), b3 + hstep, voffB); PG8_STAGE_A(PG8_SA(1, 0), a3, 0, last ? 1 : t + 3, last);
            PG8_WAIT_V(8); PG8_WAIT_L(0); PG8_BAR; PG8_MMA(1, 0, At, B0); PG8_MMA(1, 1, At, B1); PG8_BAR; PG8_SCHED;
            } else {
            PG8_LDB(B0, 0, 0); PG8_SCHED; PG8_LDA(At, 0, 0); PG8_STAGE(PG8_SA(1, 1), a1 + hstep, voffA);
            PG8_WAIT_L(8); PG8_BAR; PG8_WAIT_L(0); PG8_MMA(0, 0, At, B0); PG8_BAR; PG8_SCHED;
            PG8_LDB(B1, 0, 1); PG8_STAGE(PG8_SB(0, 0), b2, voffB);
            PG8_BAR; PG8_WAIT_L(0); PG8_MMA(0, 1, At, B1); PG8_BAR;
            PG8_LDA(At, 0, 1); PG8_STAGE(PG8_SA(0, 0), a2, voffA);
            PG8_BAR; PG8_WAIT_L(0); PG8_MMA(1, 0, At, B0); PG8_BAR; PG8_SCHED;
            PG8_STAGE(PG8_SB(0, 1), b2 + hstep, voffB);
            PG8_WAIT_V(6); PG8_BAR; PG8_MMA(1, 1, At, B1); PG8_BAR;
            PG8_LDB(B0, 1, 0); PG8_SCHED; PG8_LDA(At, 1, 0); PG8_STAGE(PG8_SA(0, 1), a2 + hstep, voffA);
            PG8_WAIT_L(8); PG8_BAR; PG8_WAIT_L(0); PG8_MMA(0, 0, At, B0); PG8_BAR; PG8_SCHED;
            PG8_LDB(B1, 1, 1); PG8_STAGE(PG8_SB(1, 0), b3, voffB);
            PG8_BAR; PG8_WAIT_L(0); PG8_MMA(0, 1, At, B1); PG8_BAR;
            PG8_LDA(At, 1, 1); PG8_STAGE(PG8_SA(1, 0), a3, voffA);
            PG8_BAR; PG8_WAIT_L(0); PG8_MMA(1, 0, At, B0); PG8_BAR; PG8_SCHED;
            PG8_STAGE(PG8_SB(1, 1), b3 + hstep, voffB);
            PG8_WAIT_V(6); PG8_BAR; PG8_MMA(1, 1, At, B1); PG8_BAR;
            }
        }
        if constexpr (ALIGN_EPI) { if (wr == 0) PG8_BAR; }
        if constexpr (!Epi::AFTER_DRAIN) { E(acc, cur, wr, wc, fr, fq); S.done(cur); }
        if (!has_next) break;
#pragma unroll
        for (int a = 0; a < 2; ++a)
#pragma unroll
            for (int b = 0; b < 2; ++b)
#pragma unroll
                for (int m = 0; m < 4; ++m)
#pragma unroll
                    for (int n = 0; n < 2; ++n) acc[a][b][m][n] = (f32x4){0.f, 0.f, 0.f, 0.f};
        if constexpr (Sched::GATHER) {
#pragma unroll
            for (int h = 0; h < 2; ++h)
#pragma unroll
                for (int i = 0; i < 2; ++i) goA[h][i] = PG8_GOFF((ui + 1) & 1, h, i); }
        cur = nxt; cA = nA; cB = nB; ++ui;
        if constexpr (ALIGN_EPI) { if (wr == 1) PG8_BAR; }
    }
    PG8_WAIT_V(0);
    if constexpr (!ALIGN_EPI) { if (wr == 0) PG8_BAR; }
    PG8_BAR;
    if constexpr (Epi::AFTER_DRAIN) { E.fused(acc, cur, wr, wc, fr, fq, lds, wid, lane); S.done(cur); }
#undef PG8_SA
#undef PG8_SB
#undef PG8_STAGE
#undef PG8_STAGE_A
#undef PG8_GOFF
#undef PG8_LDA
#undef PG8_LDB
#undef PG8_MMA
#undef PG8_WAIT_V
#undef PG8_WAIT_L
#undef PG8_BAR
#undef PG8_SCHED
}
}

constexpr int DM = 1024, NBATCH = 32, SEQ = 2048, CTXL = 256, DEPTH = 4;
constexpr int M_LAT = NBATCH * SEQ, M_CTX = NBATCH * CTXL, M_ALL = M_LAT + M_CTX;
constexpr int DIN = 3840, DFF = 2816, NEXP = 8;
constexpr int PA_Q = 0, PA_K = 256, PA_V = 512, PB_Q = 768, PB_I = 1280, PB_FF = 1792, PB_FB = 2304, PB_G = 2816, PC_Q = 3328, PC_K = 3584, PC_V = 3712;
constexpr float NORM_EPS = 1e-6f;
constexpr int NWAVES = 8, NTHREADS = 512;

constexpr size_t MiB = 1u << 20;
constexpr size_t WS_CTL = 0, CTL_ZERO_BYTES = 1 * MiB;
constexpr size_t WS_MOD = 1 * MiB;
constexpr int MOE_MAXR = 75776;
constexpr size_t WS_ROWINFO = 5 * MiB;
constexpr size_t WS_TOK = 6 * MiB + 512 * 1024;
constexpr size_t WS_WGT = 7 * MiB + 128 * 1024;
constexpr size_t WS_CNT = 7 * MiB + 896 * 1024;
constexpr size_t WS_CTXRES = 8 * MiB;
constexpr size_t WS_WINT = 40 * MiB;
constexpr size_t WS_WOUTT = 70 * MiB;
constexpr size_t WS_W13T = 78 * MiB;
constexpr size_t WS_W2T = 100 * MiB;
constexpr size_t WS_MW13T = 112 * MiB;
constexpr size_t WS_MW2T = 200 * MiB;
constexpr size_t WS_XB = 244 * MiB;
constexpr size_t WS_BIG = 388 * MiB;
constexpr size_t WS_HIDM = WS_BIG + 148 * MiB;
constexpr size_t WS_ACT2 = WS_BIG + 400 * MiB;
constexpr size_t WS_BG1 = 972 * MiB;
constexpr size_t WS_BF1 = 974 * MiB;
constexpr size_t WS_GSC = 976 * MiB;
constexpr size_t WS_SSP = 977 * MiB;
constexpr size_t WS_SBF = 982 * MiB;
constexpr size_t WS_END = 985 * MiB;
constexpr int CW_BAR = 4096;

constexpr int RING_OFF = 0, RING_BYTES = 131072;
constexpr int LDSCTL_OFF = 146944, LDS_BYTES = 147456;

#define GAS __attribute__((address_space(1)))
#define LAS __attribute__((address_space(3)))
typedef unsigned short bf16;
typedef unsigned v4u __attribute__((ext_vector_type(4)));
typedef unsigned v2u __attribute__((ext_vector_type(2)));
typedef float f32x4 __attribute__((ext_vector_type(4)));
typedef GAS unsigned gu32;
#define LDS_WAIT() asm volatile("s_waitcnt lgkmcnt(0)" ::: "memory")
__device__ __forceinline__ unsigned f2bf(float f) { unsigned u = __builtin_bit_cast(unsigned, f); return (u + 0x7fffu + ((u >> 16) & 1u)) >> 16; }
typedef float f32x2_t __attribute__((ext_vector_type(2))); typedef __bf16 bf16x2_t __attribute__((ext_vector_type(2)));
__device__ __forceinline__ unsigned pk2(float lo, float hi) { f32x2_t v = {lo, hi}; bf16x2_t b = __builtin_convertvector(v, bf16x2_t); return __builtin_bit_cast(unsigned, b); }
__device__ __forceinline__ float bflo(unsigned u) { return __builtin_bit_cast(float, u << 16); }
__device__ __forceinline__ float bfhi(unsigned u) { return __builtin_bit_cast(float, u & 0xffff0000u); }
__device__ __forceinline__ float wave_sum(float v, int lane) {
#pragma unroll
    for (int o = 1; o < 64; o <<= 1) v += __builtin_bit_cast(float, __builtin_amdgcn_ds_bpermute((lane ^ o) << 2, __builtin_bit_cast(int, v)));
    return v;
}
__device__ __forceinline__ float wave_max(float v, int lane) {
#pragma unroll
    for (int o = 1; o < 64; o <<= 1) v = fmaxf(v, __builtin_bit_cast(float, __builtin_amdgcn_ds_bpermute((lane ^ o) << 2, __builtin_bit_cast(int, v))));
    return v;
}
__device__ __forceinline__ float sigmoid_f(float x) { return __builtin_amdgcn_rcpf(1.f + __expf(-x)); }
__device__ __forceinline__ float silu1(float a) { return a * __builtin_amdgcn_rcpf(1.f + __expf(-a)); }
#define XB_TMO      128
#define XB_XCNT(j)  (256  + 64 * (j))
#define XB_XSUB(j)  (1280 + 64 * (j))
#define XB_XGEN(j)  (2304 + 64 * (j))
#define XB_TOP      3328
#define XB_TOPGEN   3392
#define XCD_BAR_WORDS 3456
#define XB_SPIN_CAP (1u << 24)

__device__ __forceinline__ unsigned xb_ld(unsigned* p)              { return __hip_atomic_load(p, __ATOMIC_RELAXED, __HIP_MEMORY_SCOPE_AGENT); }
__device__ __forceinline__ unsigned xb_add(unsigned* p, unsigned v) { return __hip_atomic_fetch_add(p, v, __ATOMIC_RELAXED, __HIP_MEMORY_SCOPE_AGENT); }
__device__ __forceinline__ unsigned xb_xcc_id() { return (unsigned)__builtin_amdgcn_s_getreg((3 << 11) | 20) & 0xFu; }
#define XB_SPIN(cond, bar) do { unsigned _sp = 0; while (cond) { __builtin_amdgcn_s_sleep(1); \
    if ((++_sp & 255u) == 0u) { if (xb_ld(&(bar)[XB_TMO])) break; if (_sp > XB_SPIN_CAP) { atomicAdd(&(bar)[XB_TMO], 1u); break; } } } } while (0)

struct XcdBarrier {
    unsigned* bar; unsigned x;
    volatile LAS unsigned* st;
};

__device__ __forceinline__ XcdBarrier xcd_barrier_post(unsigned* bar, volatile LAS unsigned* st) {
    XcdBarrier b; b.bar = bar; b.x = xb_xcc_id(); b.st = st;
    if (threadIdx.x == 0) (void)xb_add(&bar[XB_XCNT(b.x)], 1u);
    return b;
}
__device__ __forceinline__ void xcd_barrier_complete(unsigned* bar, unsigned x, unsigned& nloc, unsigned& nx) {
    const unsigned G = gridDim.x * gridDim.y * gridDim.z;
    unsigned sum, cnt, mine, sp = 0u;
    for (;;) {
        sum = 0u; cnt = 0u; mine = 0u;
#pragma unroll
        for (unsigned j = 0; j < 16; ++j) { const unsigned c = xb_ld(&bar[XB_XCNT(j)]); sum += c; cnt += (c > 0u) ? 1u : 0u; mine = (j == x) ? c : mine; }
        if (sum == G) break;
        __builtin_amdgcn_s_sleep(1);
        if ((++sp & 255u) == 0u) { if (xb_ld(&bar[XB_TMO])) break; if (sp > XB_SPIN_CAP) { atomicAdd(&bar[XB_TMO], 1u); break; } }
    }
    nloc = mine > 0u ? mine : 1u; nx = cnt > 0u ? cnt : 1u;
}

__device__ __forceinline__ void xcd_barrier(const XcdBarrier& b) {
    asm volatile("s_waitcnt vmcnt(0)" ::: "memory");
    __syncthreads();
    if (threadIdx.x == 0) {
        unsigned* bar = b.bar;
        __builtin_amdgcn_s_waitcnt(0);
        unsigned nloc = b.st[0], nx = b.st[1];
        if (nloc == 0u) { xcd_barrier_complete(bar, b.x, nloc, nx); b.st[0] = nloc; b.st[1] = nx; }
        const unsigned old = xb_add(&bar[XB_XSUB(b.x)], 1u);
        const unsigned gen = old / nloc;
        if (old + 1u == (gen + 1u) * nloc) {
            __builtin_amdgcn_fence(__ATOMIC_RELEASE, "agent");
            asm volatile("s_waitcnt vmcnt(0)" ::: "memory");
            const unsigned og = xb_add(&bar[XB_TOP], 1u);
            const unsigned tg = og / nx;
            if (og + 1u == (tg + 1u) * nx) xb_add(&bar[XB_TOPGEN], 1u);
            else XB_SPIN(xb_ld(&bar[XB_TOPGEN]) == tg, bar);
            __builtin_amdgcn_fence(__ATOMIC_ACQUIRE, "agent");
            xb_add(&bar[XB_XGEN(b.x)], 1u);
            asm volatile("s_waitcnt vmcnt(0)" ::: "memory");
        } else {
            XB_SPIN(xb_ld(&bar[XB_XGEN(b.x)]) == gen, bar);
            __builtin_amdgcn_fence(__ATOMIC_ACQUIRE, "agent");
            asm volatile("s_waitcnt vmcnt(0)" ::: "memory");
        }
    }
    __syncthreads();
}


struct Frame { LAS unsigned char* lds; volatile LAS unsigned* MISC; int tid, lane, wave, vcu, G; };
constexpr int SEGT_OFF = LDSCTL_OFF + 336, BASE_OFF = LDSCTL_OFF + 408;
constexpr int PTR_OFF = LDSCTL_OFF + 128;
__device__ __forceinline__ unsigned long long ldp64(const Frame& F, int i) {
    const volatile LAS unsigned* p = (const volatile LAS unsigned*)(F.lds + PTR_OFF) + 2 * i;
    const unsigned lo = __builtin_amdgcn_readfirstlane(p[0]), hi = __builtin_amdgcn_readfirstlane(p[1]);
    return ((unsigned long long)hi << 32) | lo;
}
#define INP(i) ((const float*)ldp64(F, (i)))
#define OUTP() ((float*)ldp64(F, 24))
#define ACTP() ((bf16*)ldp64(F, 24))
#define WSP() ((unsigned char*)ldp64(F, 25))

__device__ __forceinline__ int win_row_of_col(int c) {
    if (c < 512) { const int d = c & 31, fq = 2 * (d >> 4) + ((d >> 2) & 1), n = (d >> 3) & 1; return (c & ~31) + 8 * fq + 4 * n + (d & 3); }
    if (c >= 3328) { const int e = c - 3328, pn = 13 + (e >> 8), wc = (e >> 6) & 3, dd = e & 63; return pn * 256 + 128 * (dd >> 5) + 32 * wc + 8 * ((dd >> 2) & 3) + 4 * ((dd >> 4) & 1) + (dd & 3); }
    { const int e = c & 255; return (c & ~255) + 128 * ((e >> 5) & 1) + 32 * (e >> 6) + (e & 31); }
}
__device__ __forceinline__ void tr_item(const float* W, int N, bf16* WT, int K, int drow0, int k0, int n0, LAS float* scr, int lane, bool perm_win = false) {
    const int kr = lane >> 4, nc = (lane & 15) * 4;
    f32x4 v[16];
#pragma unroll
    for (int i = 0; i < 16; ++i) v[i] = *(const GAS f32x4*)(W + (size_t)(k0 + 4 * i + kr) * N + n0 + nc);
#pragma unroll
    for (int i = 0; i < 16; ++i) { LAS float* d = scr + (4 * i + kr) * 65 + nc; d[0] = v[i][0]; d[1] = v[i][1]; d[2] = v[i][2]; d[3] = v[i][3]; }
    LDS_WAIT(); asm volatile("" ::: "memory");
    const int c = lane & 7;
#pragma unroll
    for (int j = 0; j < 8; ++j) { const int n = (lane >> 3) + 8 * j; const LAS float* sp = scr + (8 * c) * 65 + n;
        v4u o; o.x = pk2(sp[0 * 65], sp[1 * 65]); o.y = pk2(sp[2 * 65], sp[3 * 65]); o.z = pk2(sp[4 * 65], sp[5 * 65]); o.w = pk2(sp[6 * 65], sp[7 * 65]);
        *(GAS v4u*)(WT + (size_t)(perm_win ? win_row_of_col(drow0 + n) : drow0 + n) * K + k0 + 8 * c) = o; }
    LDS_WAIT(); asm volatile("" ::: "memory");
}
__device__ __forceinline__ void tr_matrix(Frame& F, const float* W, int K, int N, bf16* WT, int mode, int& base, LAS float* scr) {
    const int gw = F.vcu * NWAVES + F.wave, NGW = F.G * NWAVES;
    const int nblk = N / 64, nitems = (K / 64) * nblk;
    int start = (gw - base) % NGW; if (start < 0) start += NGW;
    for (int it = start; it < nitems; it += NGW) { const int kb = it / nblk, nb = it % nblk, n0 = nb * 64;
        const int drow0 = (mode == 0 || mode == 3) ? n0 : ((n0 >> 7) * 256 + (mode - 1) * 128 + (n0 & 127));
        tr_item(W, N, WT, K, drow0, kb * 64, n0, scr, F.lane, mode == 3); }
    base += nitems;
}
__device__ __forceinline__ void mod_partial(Frame& F, const float* c, const float* cctx, const float* ada_w, float* PART) {
    LAS float* s = (LAS float*)F.lds;
    for (int i = F.tid; i < 33 * 1024; i += NTHREADS) { const float v = i < 32 * 1024 ? c[i] : cctx[i - 32 * 1024]; s[i] = silu1(v); }
    __syncthreads();
    const int gw = F.vcu * NWAVES + F.wave, NGW = F.G * NWAVES;
    for (int it = gw; it < 4 * 24 * 3 * 8; it += NGW) {
        const int kc = it & 7, rg = (it >> 3) % 3, cb = (it / 24) % 24, L = it / 576;
        const GAS float* wbase = (const GAS float*)ada_w + (size_t)L * 1024 * 6144 + (size_t)(kc * 128) * 6144 + cb * 256;
        f32x4 acc[11];
#pragma unroll
        for (int r = 0; r < 11; ++r) acc[r] = (f32x4){0.f, 0.f, 0.f, 0.f};
#pragma unroll 1
        for (int k = 0; k < 128; k += 16) {
            const GAS float* wk = wbase + (size_t)k * 6144;
            f32x4 wv[16];
#pragma unroll
            for (int kk = 0; kk < 16; ++kk) wv[kk] = *(const GAS f32x4*)(wk + kk * 6144 + F.lane * 4);
#pragma unroll
            for (int k4 = 0; k4 < 4; ++k4)
#pragma unroll
                for (int r = 0; r < 11; ++r) { const f32x4 sv = *(const LAS f32x4*)(s + (rg * 11 + r) * 1024 + kc * 128 + k + 4 * k4);
                    acc[r] += (wv[4 * k4] * sv[0] + wv[4 * k4 + 1] * sv[1]) + (wv[4 * k4 + 2] * sv[2] + wv[4 * k4 + 3] * sv[3]); }
        }
#pragma unroll
        for (int r = 0; r < 11; ++r) *(GAS f32x4*)(PART + (((size_t)kc * 4 + L) * 33 + rg * 11 + r) * 6144 + cb * 256 + F.lane * 4) = acc[r];
    }
    __syncthreads();
}
__device__ __forceinline__ void mod_finalize(Frame& F, const float* PART, const float* ada_b, float* MOD, bf16* SBF) {
    { const v4u z = {0u, 0u, 0u, 0u};
#pragma unroll 1
      for (int i = F.vcu * NTHREADS + F.tid; i < 5 * 223 * 128; i += F.G * NTHREADS) { const int t = i / (223 * 128), q = i % (223 * 128); *(GAS v4u*)(SBF + ((size_t)t * 256 + 33) * 1024 + (size_t)q * 8) = z; } }
#pragma unroll 1
    for (int i = F.vcu * NTHREADS + F.tid; i < 4 * 33 * 1536; i += F.G * NTHREADS) {
        const int n = (i % 1536) * 4, lr = i / 1536, L = lr / 33, r = lr % 33;
        f32x4 v = *(const GAS f32x4*)(ada_b + L * 6144 + n);
#pragma unroll
        for (int kc = 0; kc < 8; ++kc) v += *(const GAS f32x4*)(PART + (((size_t)kc * 4 + L) * 33 + r) * 6144 + n);
        *(GAS f32x4*)(MOD + ((size_t)L * 33 + r) * 6144 + n) = v;
        const int chunk = n >> 10, sbt = (chunk == 0 && L >= 1) ? L - 1 : ((chunk == 3 && !(L & 1)) ? 3 + (L >> 1) : -1);
        if (sbt >= 0) { v2u o; o.x = pk2(v[0], v[1]); o.y = pk2(v[2], v[3]); *(GAS v2u*)(SBF + ((size_t)sbt * 256 + r) * 1024 + (n & 1023)) = o; }
    }
}

template <bool ROUTE, bool XF32>
__device__ __forceinline__ void norm_phase(Frame& F, const void* xl_, const void* xc_, bf16* xb, int nrows, const float* gain, const float* modL, int sh, int sc, bf16* out, const float* router, int* rowinfo, int* cntg, int* tok) {
    LAS float* rt = (LAS float*)F.lds;
    LAS int* cnt = (LAS int*)(F.lds + 32768);
    float rw[8][16];
    if (ROUTE) {
#pragma unroll
        for (int j = 0; j < 4; ++j)
#pragma unroll
            for (int i = 0; i < 4; ++i) { const GAS f32x4* rp = (const GAS f32x4*)(router + (size_t)(4 * F.lane + 256 * j + i) * 8); const f32x4 a = rp[0], b = rp[1];
                rw[0][4 * j + i] = a[0]; rw[1][4 * j + i] = a[1]; rw[2][4 * j + i] = a[2]; rw[3][4 * j + i] = a[3]; rw[4][4 * j + i] = b[0]; rw[5][4 * j + i] = b[1]; rw[6][4 * j + i] = b[2]; rw[7][4 * j + i] = b[3]; }
        if (F.tid < 16) cnt[F.tid] = 0;
        { int i = F.vcu * NTHREADS + F.tid; while (i < 2 * MOE_MAXR) { tok[i] = -1; i += F.G * NTHREADS; asm volatile("" : "+v"(i)); } }
        __syncthreads(); }
    const int gw = F.vcu * NWAVES + F.wave, NGW = F.G * NWAVES, lane = F.lane;
    f32x4 gv[4];
#pragma unroll
    for (int j = 0; j < 4; ++j) gv[j] = *(const GAS f32x4*)(gain + 4 * lane + 256 * j);
    const float* xl = (const float*)xl_; const float* xc = (const float*)xc_; const bf16* xlb = (const bf16*)xl_; const bf16* xcb = (const bf16*)xc_;
    f32x4 vn[4]; v2u un[4];
#define NP_LOAD(rr) do { if (XF32) { const float* src_ = (rr) < M_LAT ? xl + (size_t)(rr) * DM : xc + (size_t)((rr) - M_LAT) * DM; \
            _Pragma("unroll") for (int j_ = 0; j_ < 4; ++j_) vn[j_] = *(const GAS f32x4*)(src_ + 4 * lane + 256 * j_); } \
        else { const bf16* src_ = (rr) < M_LAT ? xlb + (size_t)(rr) * DM : xcb + (size_t)((rr) - M_LAT) * DM; \
            _Pragma("unroll") for (int j_ = 0; j_ < 4; ++j_) un[j_] = *(const GAS v2u*)(src_ + 4 * lane + 256 * j_); } } while (0)
    if (gw < nrows) NP_LOAD(gw);
    for (int r = gw; r < nrows; r += NGW) {
        const bool lat = r < M_LAT;
        const float* md = modL + (size_t)(lat ? (r >> 11) : 32) * 6144;
        f32x4 v[4]; float ss = 0.f;
#pragma unroll
        for (int j = 0; j < 4; ++j) { if (XF32) v[j] = vn[j]; else { v[j][0] = bflo(un[j].x); v[j][1] = bfhi(un[j].x); v[j][2] = bflo(un[j].y); v[j][3] = bfhi(un[j].y); } }
        if (XF32 && xb) {
#pragma unroll
            for (int j = 0; j < 4; ++j) { v2u o; o.x = pk2(v[j][0], v[j][1]); o.y = pk2(v[j][2], v[j][3]); *(GAS v2u*)(xb + (size_t)r * DM + 4 * lane + 256 * j) = o; } }
        f32x4 scq[4], shq[4];
#pragma unroll
        for (int j = 0; j < 4; ++j) { scq[j] = *(const GAS f32x4*)(md + sc * 1024 + 4 * lane + 256 * j); shq[j] = *(const GAS f32x4*)(md + sh * 1024 + 4 * lane + 256 * j); }
        { const int rn = r + NGW; if (rn < nrows) NP_LOAD(rn); }
#pragma unroll
        for (int j = 0; j < 4; ++j) ss += (v[j][0] * v[j][0] + v[j][1] * v[j][1]) + (v[j][2] * v[j][2] + v[j][3] * v[j][3]);
        ss = wave_sum(ss, lane);
        const float rstd = rsqrtf(ss * (1.f / DM) + NORM_EPS);
#pragma unroll
        for (int j = 0; j < 4; ++j) { const f32x4 scv = scq[j], shv = shq[j];
            v[j] = (v[j] * rstd * gv[j]) * (scv + 1.f) + shv;
            v2u o; o.x = pk2(v[j][0], v[j][1]); o.y = pk2(v[j][2], v[j][3]);
            *(GAS v2u*)(out + (size_t)r * DM + 4 * lane + 256 * j) = o; }
        if (ROUTE) {
            float pp[8];
#pragma unroll
            for (int e = 0; e < 8; ++e) { float p = 0.f;
#pragma unroll
                for (int j = 0; j < 4; ++j) p += (v[j][0] * rw[e][4 * j] + v[j][1] * rw[e][4 * j + 1]) + (v[j][2] * rw[e][4 * j + 2] + v[j][3] * rw[e][4 * j + 3]);
                pp[e] = p; }
            float q4[4], q2[2], q1;
            { const bool up = (lane & 4) != 0;
#pragma unroll
              for (int e = 0; e < 4; ++e) { const float keep = up ? pp[4 + e] : pp[e], give = up ? pp[e] : pp[4 + e]; q4[e] = keep + __builtin_bit_cast(float, __builtin_amdgcn_ds_bpermute((lane ^ 4) << 2, __builtin_bit_cast(int, give))); } }
            { const bool up = (lane & 2) != 0;
#pragma unroll
              for (int e = 0; e < 2; ++e) { const float keep = up ? q4[2 + e] : q4[e], give = up ? q4[e] : q4[2 + e]; q2[e] = keep + __builtin_bit_cast(float, __builtin_amdgcn_ds_bpermute((lane ^ 2) << 2, __builtin_bit_cast(int, give))); } }
            { const bool up = (lane & 1) != 0; const float keep = up ? q2[1] : q2[0], give = up ? q2[0] : q2[1]; q1 = keep + __builtin_bit_cast(float, __builtin_amdgcn_ds_bpermute((lane ^ 1) << 2, __builtin_bit_cast(int, give))); }
#pragma unroll
            for (int o = 8; o < 64; o <<= 1) q1 += __builtin_bit_cast(float, __builtin_amdgcn_ds_bpermute((lane ^ o) << 2, __builtin_bit_cast(int, q1)));
            float lg[8];
#pragma unroll
            for (int e = 0; e < 8; ++e) lg[e] = __builtin_bit_cast(float, __builtin_amdgcn_ds_bpermute(e << 2, __builtin_bit_cast(int, q1)));
            int i1 = 0; float v1 = lg[0];
#pragma unroll
            for (int e = 1; e < 8; ++e) if (lg[e] > v1) { v1 = lg[e]; i1 = e; }
            int i2 = -1; float v2 = -3.0e38f;
#pragma unroll
            for (int e = 0; e < 8; ++e) if (e != i1 && lg[e] > v2) { v2 = lg[e]; i2 = e; }
            const float wa = 1.f / (1.f + expf(v2 - v1)), wb = 1.f - wa;
            if (lane == 0) { const int l1 = __hip_atomic_fetch_add(cnt + i1, 1, __ATOMIC_RELAXED, __HIP_MEMORY_SCOPE_WORKGROUP), l2 = __hip_atomic_fetch_add(cnt + 8 + i2, 1, __ATOMIC_RELAXED, __HIP_MEMORY_SCOPE_WORKGROUP);
                v4u ri; ri.x = (unsigned)(i1 | (l1 << 4)); ri.y = __builtin_bit_cast(unsigned, wa); ri.z = (unsigned)(i2 | (l2 << 4)); ri.w = __builtin_bit_cast(unsigned, wb);
                *(GAS v4u*)(rowinfo + (size_t)r * 4) = ri; }
        }
    }
#undef NP_LOAD
    if (ROUTE) { __syncthreads(); if (F.tid < 16) cntg[F.vcu * 16 + F.tid] = cnt[F.tid]; }
}
__device__ __forceinline__ void moe_setup(Frame& F, const int* cntg) {
    LAS int* tmp = (LAS int*)F.lds; volatile LAS int* SEGT = (volatile LAS int*)(F.lds + SEGT_OFF); volatile LAS int* BASE = (volatile LAS int*)(F.lds + BASE_OFF);
    __syncthreads();
    for (int i = F.tid; i < F.G * 16; i += NTHREADS) tmp[i] = cntg[i];
    __syncthreads();
    if (F.tid < 16) { int tot = 0, bef = 0; for (int w = 0; w < F.G; ++w) { const int c = tmp[w * 16 + F.tid]; tot += c; bef += w < F.vcu ? c : 0; } tmp[4096 + F.tid] = tot; tmp[4112 + F.tid] = bef; }
    __syncthreads();
    if (F.tid < 2) { int off = 0; for (int e = 0; e < 8; ++e) { SEGT[F.tid * 9 + e] = off >> 8; off += (tmp[4096 + F.tid * 8 + e] + 255) & ~255; } SEGT[F.tid * 9 + 8] = off >> 8; }
    __syncthreads();
    if (F.tid < 16) BASE[F.tid] = SEGT[(F.tid >> 3) * 9 + (F.tid & 7)] * 256 + tmp[4112 + F.tid];
    __syncthreads();
}
__device__ __forceinline__ void moe_gather(Frame& F, int s, int nrows, const bf16* act, bf16* h2s, const int* rowinfo, int* tok, float* wgt) {
    const int gw = F.vcu * NWAVES + F.wave, NGW = F.G * NWAVES, lane = F.lane; volatile LAS int* BASE = (volatile LAS int*)(F.lds + BASE_OFF);
    for (int r = gw; r < nrows; r += NGW) {
        const unsigned code = (unsigned)__builtin_amdgcn_readfirstlane(rowinfo[(size_t)r * 4 + 2 * s]);
        const int e = code & 15, dest = BASE[s * 8 + e] + (int)(code >> 4);
        if (lane == 0) { tok[s * MOE_MAXR + dest] = r; wgt[s * MOE_MAXR + dest] = __builtin_bit_cast(float, rowinfo[(size_t)r * 4 + 2 * s + 1]); }
    }
}

__device__ __forceinline__ void unpack8(const v4u u, float* x) { x[0] = bflo(u.x); x[1] = bfhi(u.x); x[2] = bflo(u.y); x[3] = bfhi(u.y); x[4] = bflo(u.z); x[5] = bfhi(u.z); x[6] = bflo(u.w); x[7] = bfhi(u.w); }
__device__ __forceinline__ v4u pack8(const float* x) { v4u o; o.x = pk2(x[0], x[1]); o.y = pk2(x[2], x[3]); o.z = pk2(x[4], x[5]); o.w = pk2(x[6], x[7]); return o; }

typedef float f32x16 __attribute__((ext_vector_type(16)));
typedef short s16x8 __attribute__((ext_vector_type(8)));
__device__ __forceinline__ unsigned cvtpk_s(float lo, float hi) { return pk2(lo, hi); }
#define MFMA32(a, b, c) __builtin_amdgcn_mfma_f32_32x32x16_bf16((a), (b), (c), 0, 0, 0)
typedef short v4i16_t __attribute__((ext_vector_type(4)));
__device__ __forceinline__ v2u ds_tr16(const LAS unsigned char* p) { return __builtin_bit_cast(v2u, __builtin_amdgcn_ds_read_tr16_b64_v4i16((LAS v4i16_t*)p)); }
#define VT_ADDR(vbase, key0, c0) ((vbase) + ((key0) + ((lane & 15) >> 2)) * 192 + ((c0) + 16 * ((lane >> 4) & 1) + 4 * (lane & 3)) * 2)
__device__ __forceinline__ float add1(float a, float b) { float d; asm("v_add_f32_e32 %0, %1, %2" : "=v"(d) : "v"(a), "v"(b)); return d; }
__device__ __forceinline__ float sum16(const f32x16& S) {
    const float a0 = add1(S[0], S[1]), a1 = add1(S[2], S[3]), a2 = add1(S[4], S[5]), a3 = add1(S[6], S[7]), a4 = add1(S[8], S[9]), a5 = add1(S[10], S[11]), a6 = add1(S[12], S[13]), a7 = add1(S[14], S[15]);
    return add1(add1(add1(a0, a1), add1(a2, a3)), add1(add1(a4, a5), add1(a6, a7))); }
__device__ __forceinline__ float xor32_add(float v, int lane) { return v + __builtin_bit_cast(float, __builtin_amdgcn_ds_bpermute((lane ^ 32) << 2, __builtin_bit_cast(int, v))); }
__device__ __forceinline__ void hgrn_item(Frame& F, bf16* proj, int b, int h, int dir, const float* lbl, int L, bool do_store = true) {
    LAS unsigned char* const OPS = F.lds;
    LAS unsigned char* const RAW = F.lds + 76800;
    LAS float* const TOT = (LAS float*)(F.lds + 101376); LAS float* const LBS = (LAS float*)(F.lds + 105472); LAS float* const OR = (LAS float*)(F.lds + 105984);
    LAS unsigned char* const PB = F.lds + 138752;
    __syncthreads();
    if (F.tid < 128) { const int ch = h * 128 + F.tid; float e[4], mx = -3.0e38f, sum = 0.f, lb = 0.f;
#pragma unroll
        for (int l = 0; l < 4; ++l) { e[l] = lbl[((size_t)dir * 4 + l) * 512 + ch]; mx = fmaxf(mx, e[l]); }
#pragma unroll
        for (int l = 0; l < 4; ++l) { e[l] = expf(e[l] - mx); sum += e[l]; }
#pragma unroll
        for (int l = 1; l < 4; ++l) if (l <= L) lb += e[l] / sum;
        LBS[F.tid] = lb; }
    const int lane = F.lane, r = lane & 31, hh = lane >> 5, vt = F.wave & 3, p = F.wave >> 2;
    const int kp = F.tid & 63, tq = F.tid >> 6;
    const int fcol = (dir ? PB_FB : PB_FF) + h * 128, rstep = dir ? -1 : 1;
#define HG_ROW0(c) ((c) < 8 ? M_LAT + b * 256 + (dir ? 255 - 32 * (c) : 32 * (c)) : b * 2048 + (dir ? 2047 - (32 * (c) - 256) : 32 * (c) - 256))
#define HG_DMA(c) do { const int trow_ = HG_ROW0(c) + rstep * (4 * F.wave + (lane >> 4)); const bf16* pr_ = proj + (size_t)trow_ * DIN + h * 128 + (lane & 15) * 8; \
        LAS unsigned char* dst_ = RAW + F.wave * 1024; \
        __builtin_amdgcn_global_load_lds((const unsigned*)(pr_ + PB_Q), (LAS unsigned*)(dst_), 16, 0, 0); \
        __builtin_amdgcn_global_load_lds((const unsigned*)(pr_ + PB_I), (LAS unsigned*)(dst_ + 8192), 16, 0, 0); \
        __builtin_amdgcn_global_load_lds((const unsigned*)(proj + (size_t)trow_ * DIN + fcol + (lane & 15) * 8), (LAS unsigned*)(dst_ + 16384), 16, 0, 0); } while (0)
#define HG_BAR() do { asm volatile("s_waitcnt lgkmcnt(0)" ::: "memory"); __builtin_amdgcn_s_barrier(); asm volatile("" ::: "memory"); } while (0)
#define HG_STAGE_A() do { const LAS unsigned char* rq = RAW + (4 * tq) * 256 + kp * 4; unsigned uq[4], uf[4]; \
        _Pragma("unroll") for (int j = 0; j < 4; ++j) { uq[j] = *(const LAS unsigned*)(rq + j * 256); iw[j] = *(const LAS unsigned*)(rq + 8192 + j * 256); uf[j] = *(const LAS unsigned*)(rq + 16384 + j * 256); } \
        float run0 = 1.f, run1 = 1.f; \
        _Pragma("unroll") for (int j = 0; j < 4; ++j) { const float ka = (1.f - lb0) * __builtin_amdgcn_rcpf(1.f + __expf(bflo(uf[j]))), kb = (1.f - lb1) * __builtin_amdgcn_rcpf(1.f + __expf(bfhi(uf[j]))); \
            run0 *= fmaxf(1.f - ka, 9.36e-14f); run1 *= fmaxf(1.f - kb, 9.36e-14f);     c0[j] = run0; c1[j] = run1; k0v[j] = ka; k1v[j] = kb; q0[j] = bflo(uq[j]); q1[j] = bfhi(uq[j]); }     \
        *(LAS f32x2_t*)(TOT + tq * 128 + 2 * kp) = (f32x2_t){run0, run1}; } while (0)
#define HG_STAGE_B(ob) do { LAS unsigned char* const QAw = (ob); LAS unsigned char* const KHw = (ob) + 8704; LAS unsigned char* const KCTw = (ob) + 17408; LAS unsigned char* const ITw = (ob) + 27648; LAS float* const Dvw = (LAS float*)((ob) + 37888); \
        float off0 = 1.f, off1 = 1.f, cl0 = 1.f, cl1 = 1.f; \
        _Pragma("unroll") for (int g = 0; g < 8; ++g) { const f32x2_t tv = *(const LAS f32x2_t*)(TOT + g * 128 + 2 * kp); cl0 *= tv[0]; cl1 *= tv[1]; if (g < tq) { off0 *= tv[0]; off1 *= tv[1]; } } \
        float kc0[4], kc1[4]; \
        _Pragma("unroll") for (int j = 0; j < 4; ++j) { const int t = 4 * tq + j; const float cu0 = c0[j] * off0, cu1 = c1[j] * off1;     \
            const float r0 = fminf(__builtin_amdgcn_rcpf(cu0), 5.5e34f), r1 = fminf(__builtin_amdgcn_rcpf(cu1), 5.5e34f);     \
            *(LAS unsigned*)(QAw + t * 272 + kp * 4) = pk2(q0[j] * cu0, q1[j] * cu1); \
            *(LAS unsigned*)(KHw + t * 272 + kp * 4) = pk2(k0v[j] * r0, k1v[j] * r1); \
            kc0[j] = k0v[j] * (cl0 * r0); kc1[j] = k1v[j] * (cl1 * r1); } \
        { v2u w0; w0.x = pk2(kc0[0], kc0[1]); w0.y = pk2(kc0[2], kc0[3]); *(LAS v2u*)(KCTw + (2 * kp) * 80 + tq * 8) = w0; \
          v2u w1; w1.x = pk2(kc1[0], kc1[1]); w1.y = pk2(kc1[2], kc1[3]); *(LAS v2u*)(KCTw + (2 * kp + 1) * 80 + tq * 8) = w1; } \
        { v2u w0; w0.x = (iw[0] & 0xffffu) | (iw[1] << 16); w0.y = (iw[2] & 0xffffu) | (iw[3] << 16); *(LAS v2u*)(ITw + (2 * kp) * 80 + tq * 8) = w0; \
          v2u w1; w1.x = (iw[0] >> 16) | (iw[1] & 0xffff0000u); w1.y = (iw[2] >> 16) | (iw[3] & 0xffff0000u); *(LAS v2u*)(ITw + (2 * kp + 1) * 80 + tq * 8) = w1; } \
        if (tq == 0) *(LAS f32x2_t*)(Dvw + 2 * kp) = (f32x2_t){cl0, cl1}; } while (0)
    f32x16 S[2], Oprev;
#pragma unroll
    for (int i = 0; i < 16; ++i) { S[0][i] = 0.f; S[1][i] = 0.f; Oprev[i] = 0.f; }
    float c0[4], c1[4], q0[4], q1[4], k0v[4], k1v[4]; unsigned iw[4];
    if (F.tid < 16 * 4) { unsigned z_ = 0u; asm volatile("" : "+v"(z_)); *(LAS v2u*)(PB + (F.tid >> 2) * 80 + 32 + (F.tid & 3) * 8) = (v2u){z_, z_}; }
    HG_DMA(0);
    asm volatile("s_waitcnt vmcnt(0)" ::: "memory");
    __syncthreads();
    const float lb0 = LBS[2 * kp], lb1 = LBS[2 * kp + 1];
    HG_STAGE_A();
    HG_BAR();
    HG_DMA(1);
    HG_STAGE_B(OPS);
    asm volatile("s_waitcnt vmcnt(0)" ::: "memory");
    __syncthreads();
#pragma unroll 1
    for (int blk = 0; blk < 72; ++blk) {
        LAS unsigned char* const ob = OPS + (blk & 1) * 38400;
        LAS unsigned char* const QA = ob; LAS unsigned char* const KH = ob + 8704; LAS unsigned char* const KCT = ob + 17408; LAS unsigned char* const IT = ob + 27648; LAS float* const Dv = (LAS float*)(ob + 37888);
        const bool more = blk + 1 < 72;
        if (more) HG_STAGE_A();
        if (blk > 0 && do_store) { const LAS float* orp = OR + ((blk - 1) & 1) * 4096 + vt * 1024 + r; bf16* obp = proj + (size_t)HG_ROW0(blk - 1) * DIN + fcol + vt * 32 + r;
#pragma unroll
            for (int i8 = 0; i8 < 8; ++i8) { const int i = 8 * p + i8, t = (i & 3) + 8 * (i >> 2) + 4 * hh; const float o = (p == 0 ? Oprev[i8] : Oprev[8 + i8]) + orp[t * 32];
                ((GAS bf16*)obp)[(ptrdiff_t)(rstep * t) * DIN] = (bf16)f2bf(o); } }
        f32x16 O;
#pragma unroll
        for (int i = 0; i < 16; ++i) O[i] = 0.f;
        if (F.wave < 3) {
            const int si = F.wave >> 1, ti = (F.wave + 1) >> 1, lr = lane & 15, g = lane >> 4;
            f32x4 pt = {0.f, 0.f, 0.f, 0.f};
#pragma unroll
            for (int st = 0; st < 4; ++st) { const s16x8 ka = *(const LAS s16x8*)(KH + (16 * si + lr) * 272 + (32 * st + 8 * g) * 2), qb = *(const LAS s16x8*)(QA + (16 * ti + lr) * 272 + (32 * st + 8 * g) * 2);
                pt = __builtin_amdgcn_mfma_f32_16x16x32_bf16(ka, qb, pt, 0, 0, 0); }
            if (si == ti) {
#pragma unroll
                for (int e = 0; e < 4; ++e) pt[e] = (4 * g + e) <= lr ? pt[e] : 0.f; }
            v2u pw; pw.x = pk2(pt[0], pt[1]); pw.y = pk2(pt[2], pt[3]);
            *(LAS v2u*)(PB + (16 * ti + lr) * 80 + (16 * si + 4 * g) * 2) = pw; }
        HG_BAR();
        if (blk + 2 < 72) HG_DMA(blk + 2);
        if (more) HG_STAGE_B(OPS + ((blk + 1) & 1) * 38400);
        { const s16x8 pa = *(const LAS s16x8*)(PB + r * 80 + (16 * p + 8 * hh) * 2), bi = *(const LAS s16x8*)(IT + (vt * 32 + r) * 80 + (16 * p + 8 * hh) * 2);
          O = MFMA32(pa, bi, O); }
#pragma unroll
        for (int kti = 0; kti < 2; ++kti)
#pragma unroll
            for (int s2 = 0; s2 < 2; ++s2) { v4u sw; sw.x = cvtpk_s(S[kti][8 * s2 + 0], S[kti][8 * s2 + 1]); sw.y = cvtpk_s(S[kti][8 * s2 + 2], S[kti][8 * s2 + 3]); sw.z = cvtpk_s(S[kti][8 * s2 + 4], S[kti][8 * s2 + 5]); sw.w = cvtpk_s(S[kti][8 * s2 + 6], S[kti][8 * s2 + 7]);
                const LAS unsigned char* qp = QA + r * 272 + ((2 * p + kti) * 32 + 16 * s2 + 4 * hh) * 2; const v2u lo = *(const LAS v2u*)qp, hi = *(const LAS v2u*)(qp + 16);
                v4u aw; aw.x = lo.x; aw.y = lo.y; aw.z = hi.x; aw.w = hi.y;
                O = MFMA32(__builtin_bit_cast(s16x8, aw), __builtin_bit_cast(s16x8, sw), O); }
#pragma unroll
        for (int kti = 0; kti < 2; ++kti) {
            const int k0 = (2 * p + kti) * 32;
#pragma unroll
            for (int g4 = 0; g4 < 4; ++g4) { const f32x4 dv = *(const LAS f32x4*)(Dv + k0 + 8 * g4 + 4 * hh);
                S[kti][4 * g4] *= dv[0]; S[kti][4 * g4 + 1] *= dv[1]; S[kti][4 * g4 + 2] *= dv[2]; S[kti][4 * g4 + 3] *= dv[3]; }
#pragma unroll
            for (int s2 = 0; s2 < 2; ++s2) { const s16x8 a = *(const LAS s16x8*)(KCT + (k0 + r) * 80 + s2 * 32 + hh * 16), bi = *(const LAS s16x8*)(IT + (vt * 32 + r) * 80 + s2 * 32 + hh * 16); S[kti] = MFMA32(a, bi, S[kti]); }
        }
        { LAS float* orp = OR + (blk & 1) * 4096 + vt * 1024 + r;
#pragma unroll
          for (int i8 = 0; i8 < 8; ++i8) { const int i = 8 * (1 - p) + i8; orp[((i & 3) + 8 * (i >> 2) + 4 * hh) * 32] = (p == 0 ? O[8 + i8] : O[i8]); }
          Oprev = O; }
        asm volatile("s_waitcnt vmcnt(0)" ::: "memory");
        __syncthreads();
    }
    if (do_store) { const LAS float* orp = OR + (71 & 1) * 4096 + vt * 1024 + r; bf16* obp = proj + (size_t)HG_ROW0(71) * DIN + fcol + vt * 32 + r;
#pragma unroll
        for (int i8 = 0; i8 < 8; ++i8) { const int i = 8 * p + i8, t = (i & 3) + 8 * (i >> 2) + 4 * hh; const float o = (p == 0 ? Oprev[i8] : Oprev[8 + i8]) + orp[t * 32];
            ((GAS bf16*)obp)[(ptrdiff_t)(rstep * t) * DIN] = (bf16)f2bf(o); } }
#undef HG_ROW0
#undef HG_DMA
#undef HG_BAR
#undef HG_STAGE_A
#undef HG_STAGE_B
    __syncthreads();
}
__device__ __forceinline__ void hgrn_post_phase(Frame& F, const bf16* proj, bf16* mix, const float* ng, int nrows) {
    const int gw = F.vcu * NWAVES + F.wave, NGW = F.G * NWAVES, lane = F.lane, h = lane >> 4, c0 = (lane & 15) * 8;
    float gn[8];
#pragma unroll
    for (int e = 0; e < 8; ++e) gn[e] = ng[c0 + e];
    v4u nf, nb, ng_;
    if (gw < nrows) { const bf16* pr = proj + (size_t)gw * DIN + h * 128 + c0; nf = *(const GAS v4u*)(pr + PB_FF); nb = *(const GAS v4u*)(pr + PB_FB); ng_ = *(const GAS v4u*)(pr + PB_G); }
    for (int r = gw; r < nrows; r += NGW) {
        float of[8], ob[8], gg[8]; unpack8(nf, of); unpack8(nb, ob); unpack8(ng_, gg);
        { const int rn = r + NGW; if (rn < nrows) { const bf16* pr = proj + (size_t)rn * DIN + h * 128 + c0; nf = *(const GAS v4u*)(pr + PB_FF); nb = *(const GAS v4u*)(pr + PB_FB); ng_ = *(const GAS v4u*)(pr + PB_G); } }
        float ss = 0.f;
#pragma unroll
        for (int e = 0; e < 8; ++e) { of[e] += ob[e]; ss += of[e] * of[e]; }
#pragma unroll
        for (int o = 1; o < 16; o <<= 1) ss += __builtin_bit_cast(float, __builtin_amdgcn_ds_bpermute((lane ^ o) << 2, __builtin_bit_cast(int, ss)));
        const float rs = rsqrtf(ss * (1.f / 128.f) + NORM_EPS);
#pragma unroll
        for (int e = 0; e < 8; ++e) of[e] = of[e] * rs * gn[e] * silu1(gg[e]);
        *(GAS v4u*)(mix + (size_t)r * DM + 256 + h * 128 + c0) = pack8(of); }
}
__device__ __forceinline__ void da_item(Frame& F, const bf16* proj, bf16* mix, int b, int h, int q0, bool ctxq, float lam, float lam_init, float boundl2, const float* subg) {
    LAS unsigned char* Kb = F.lds; LAS unsigned char* Vb = F.lds + 18432;
    const int lane = F.lane, r = lane & 31, hh = lane >> 5;
    const int qrow = (ctxq ? M_LAT + b * 256 : b * 2048) + q0 + 32 * F.wave + r;
    s16x8 qf[2][2];
#pragma unroll
    for (int m = 0; m < 2; ++m)
#pragma unroll
        for (int st = 0; st < 2; ++st) qf[m][st] = *(const GAS s16x8*)(proj + (size_t)qrow * DIN + PA_Q + h * 64 + m * 32 + st * 16 + hh * 8);
    f32x16 O[2][2]; float ls[2] = {0.f, 0.f};
#pragma unroll
    for (int m = 0; m < 2; ++m)
#pragma unroll
        for (int dt = 0; dt < 2; ++dt)
#pragma unroll
            for (int i = 0; i < 16; ++i) O[m][dt][i] = 0.f;
    const int ntiles = ctxq ? 4 : 36, skey = F.tid >> 3, sch = F.tid & 7;
    v4u kreg, vreg;
    { const int j = skey; const bf16* pr = proj + (size_t)(j < 256 ? M_LAT + b * 256 + j : b * 2048 + (j - 256)) * DIN; kreg = *(const GAS v4u*)(pr + PA_K + h * 64 + sch * 8); vreg = *(const GAS v4u*)(pr + PA_V + h * 64 + sch * 8); }
    __syncthreads();
#define DA_WRITE_TILE(bufi) do { *(LAS v4u*)(Kb + (bufi) * 9216 + skey * 144 + sch * 16) = kreg; \
        *(LAS v4u*)(Vb + (bufi) * 12288 + skey * 192 + sch * 16) = vreg; } while (0)
    DA_WRITE_TILE(0);
    __syncthreads();
#pragma unroll 1
    for (int kt = 0; kt < ntiles; ++kt) {
        const int cur = kt & 1;
        if (kt + 1 < ntiles) { const int j = (kt + 1) * 64 + skey; const bf16* pr = proj + (size_t)(j < 256 ? M_LAT + b * 256 + j : b * 2048 + (j - 256)) * DIN; kreg = *(const GAS v4u*)(pr + PA_K + h * 64 + sch * 8); vreg = *(const GAS v4u*)(pr + PA_V + h * 64 + sch * 8); }
#pragma unroll
        for (int blk = 0; blk < 2; ++blk) {
            s16x8 vf[2][2];
#pragma unroll
            for (int s2 = 0; s2 < 2; ++s2)
#pragma unroll
                for (int dt = 0; dt < 2; ++dt) { const LAS unsigned char* vb_ = Vb + cur * 12288;
                    const v2u lo = ds_tr16(VT_ADDR(vb_, blk * 32 + 16 * s2 + 4 * hh, dt * 32)), hi = ds_tr16(VT_ADDR(vb_, blk * 32 + 16 * s2 + 8 + 4 * hh, dt * 32));
                    v4u vw; vw.x = lo.x; vw.y = lo.y; vw.z = hi.x; vw.w = hi.y; vf[s2][dt] = __builtin_bit_cast(s16x8, vw); }
#pragma unroll
            for (int m = 0; m < 2; ++m) {
                f32x16 S;
#pragma unroll
                for (int i = 0; i < 16; ++i) S[i] = -boundl2;
#pragma unroll
                for (int st = 0; st < 2; ++st) { const s16x8 kf = *(const LAS s16x8*)(Kb + cur * 9216 + (blk * 32 + r) * 144 + m * 64 + st * 32 + hh * 16); S = MFMA32(kf, qf[m][st], S); }
#pragma unroll
                for (int i = 0; i < 16; ++i) S[i] = __builtin_amdgcn_exp2f(S[i]);
                ls[m] = add1(ls[m], sum16(S));
#pragma unroll
                for (int s2 = 0; s2 < 2; ++s2) {
                    v4u pw; pw.x = cvtpk_s(S[8 * s2 + 0], S[8 * s2 + 1]); pw.y = cvtpk_s(S[8 * s2 + 2], S[8 * s2 + 3]); pw.z = cvtpk_s(S[8 * s2 + 4], S[8 * s2 + 5]); pw.w = cvtpk_s(S[8 * s2 + 6], S[8 * s2 + 7]);
                    const s16x8 pb = __builtin_bit_cast(s16x8, pw);
#pragma unroll
                    for (int dt = 0; dt < 2; ++dt) O[m][dt] = MFMA32(vf[s2][dt], pb, O[m][dt]);
                }
            }
        }
        if (kt + 1 < ntiles) DA_WRITE_TILE(cur ^ 1);
        __syncthreads();
    }
#undef DA_WRITE_TILE
    const float inv0 = 1.f / xor32_add(ls[0], lane), inv1 = lam / xor32_add(ls[1], lane);
    float ss = 0.f;
#pragma unroll
    for (int dt = 0; dt < 2; ++dt)
#pragma unroll
        for (int i = 0; i < 16; ++i) { const float o = O[0][dt][i] * inv0 - O[1][dt][i] * inv1; O[0][dt][i] = o; ss += o * o; }
    ss = xor32_add(ss, lane);
    const float rs = rsqrtf(ss * (1.f / 64.f) + NORM_EPS) * (1.f - lam_init);
    f32x4 sgv[2][4];
#pragma unroll
    for (int dt = 0; dt < 2; ++dt)
#pragma unroll
        for (int g4 = 0; g4 < 4; ++g4) sgv[dt][g4] = *(const GAS f32x4*)(subg + dt * 32 + 8 * g4 + 4 * hh);
#pragma unroll
    for (int dt = 0; dt < 2; ++dt)
#pragma unroll
        for (int g4 = 0; g4 < 4; ++g4) { const int dv0 = dt * 32 + 8 * g4 + 4 * hh; const f32x4 sg = sgv[dt][g4];
            v2u o; o.x = pk2(O[0][dt][4 * g4] * rs * sg[0], O[0][dt][4 * g4 + 1] * rs * sg[1]); o.y = pk2(O[0][dt][4 * g4 + 2] * rs * sg[2], O[0][dt][4 * g4 + 3] * rs * sg[3]);
            *(GAS v2u*)(mix + (size_t)qrow * DM + h * 64 + dv0) = o; }
}
__device__ __forceinline__ void sw_item(Frame& F, const bf16* proj, bf16* mix, int b, int kv, int q0, bool ctxq, const float* sink4, float boundl2) {
    LAS unsigned char* Kb = F.lds; LAS unsigned char* Vb = F.lds + 18432;
    const int lane = F.lane, r = lane & 31, hh = lane >> 5, g = F.wave & 1, qb = F.wave >> 1;
    const int qp0 = q0 + 32 * qb, qrow = (ctxq ? M_LAT + b * 256 : b * 2048) + qp0 + r;
    s16x8 qf[4];
#pragma unroll
    for (int st = 0; st < 4; ++st) qf[st] = *(const GAS s16x8*)(proj + (size_t)qrow * DIN + PC_Q + (kv * 2 + g) * 64 + st * 16 + hh * 8);
    const float sinkl2 = sink4[kv * 2 + g] * 1.4426950409f, Mx = fmaxf(boundl2, sinkl2);
    f32x16 O[2]; float ls = 0.f;
#pragma unroll
    for (int dt = 0; dt < 2; ++dt)
#pragma unroll
        for (int i = 0; i < 16; ++i) O[dt][i] = 0.f;
    const int skey = F.tid >> 3, sch = F.tid & 7;
    int wt0 = 0, wt1 = 0;
    if (!ctxq) { wt0 = q0 < 128 ? (128 - q0 + 63) / 64 - ((128 - q0) % 64 ? 1 : 0) : 0; wt1 = 6; while (wt1 > 0 && q0 - 128 + 64 * (wt1 - 1) >= SEQ) --wt1; if (q0 - 128 + 64 * wt0 + 63 < 0) ++wt0; }
    const int ntiles = 4 + (wt1 - wt0);
    v4u kreg, vreg;
#define SW_LOAD_TILE(t) do { int krow_; if ((t) < 4) krow_ = M_LAT + b * 256 + (t) * 64 + skey; else { int kp_ = q0 - 128 + 64 * ((t) - 4 + wt0) + skey; kp_ = kp_ < 0 ? 0 : (kp_ >= SEQ ? SEQ - 1 : kp_); krow_ = b * 2048 + kp_; } \
        const bf16* pr_ = proj + (size_t)krow_ * DIN; kreg = *(const GAS v4u*)(pr_ + PC_K + kv * 64 + sch * 8); vreg = *(const GAS v4u*)(pr_ + PC_V + kv * 64 + sch * 8); } while (0)
#define SW_WRITE_TILE(bufi) do { *(LAS v4u*)(Kb + (bufi) * 9216 + skey * 144 + sch * 16) = kreg; \
        *(LAS v4u*)(Vb + (bufi) * 12288 + skey * 192 + sch * 16) = vreg; } while (0)
    SW_LOAD_TILE(0);
    __syncthreads();
    SW_WRITE_TILE(0);
    __syncthreads();
#pragma unroll 1
    for (int kt = 0; kt < ntiles; ++kt) {
        const int cur = kt & 1;
        if (kt + 1 < ntiles) SW_LOAD_TILE(kt + 1);
        const bool win = kt >= 4; const int kb = q0 - 128 + 64 * (kt - 4 + wt0);
#pragma unroll
        for (int blk = 0; blk < 2; ++blk) {
            const int kbb = kb + blk * 32;
            bool need_mask = false;
            if (win) { const int dmin = qp0 - (kbb + 31), dmax = qp0 + 31 - kbb;
                if (dmax < -128 || dmin > 128 || kbb + 31 < 0 || kbb >= SEQ) continue;
                need_mask = !(dmin >= -128 && dmax <= 128 && kbb >= 0 && kbb + 31 < SEQ); }
            f32x16 S;
#pragma unroll
            for (int i = 0; i < 16; ++i) S[i] = -Mx;
#pragma unroll
            for (int st = 0; st < 4; ++st) { const s16x8 kf = *(const LAS s16x8*)(Kb + cur * 9216 + (blk * 32 + r) * 144 + st * 32 + hh * 16); S = MFMA32(kf, qf[st], S); }
#pragma unroll
            for (int i = 0; i < 16; ++i) S[i] = __builtin_amdgcn_exp2f(S[i]);
            if (need_mask) { const int kp0 = kbb + 4 * hh, d0 = qp0 + r - kp0;
#pragma unroll
                for (int i = 0; i < 16; ++i) { const int c = (i & 3) + 8 * (i >> 2); const int d = d0 - c, kp = kp0 + c; S[i] = (d <= 128 && d >= -128 && kp >= 0 && kp < SEQ) ? S[i] : 0.f; } }
            ls = add1(ls, sum16(S));
#pragma unroll
            for (int s2 = 0; s2 < 2; ++s2) {
                v4u pw; pw.x = cvtpk_s(S[8 * s2 + 0], S[8 * s2 + 1]); pw.y = cvtpk_s(S[8 * s2 + 2], S[8 * s2 + 3]); pw.z = cvtpk_s(S[8 * s2 + 4], S[8 * s2 + 5]); pw.w = cvtpk_s(S[8 * s2 + 6], S[8 * s2 + 7]);
                const s16x8 pb = __builtin_bit_cast(s16x8, pw);
#pragma unroll
                for (int dt = 0; dt < 2; ++dt) { const LAS unsigned char* vb_ = Vb + cur * 12288;
                        const v2u lo = ds_tr16(VT_ADDR(vb_, blk * 32 + 16 * s2 + 4 * hh, dt * 32)), hi = ds_tr16(VT_ADDR(vb_, blk * 32 + 16 * s2 + 8 + 4 * hh, dt * 32));
                    v4u vw; vw.x = lo.x; vw.y = lo.y; vw.z = hi.x; vw.w = hi.y;
                    O[dt] = MFMA32(__builtin_bit_cast(s16x8, vw), pb, O[dt]); }
            }
        }
        if (kt + 1 < ntiles) SW_WRITE_TILE(cur ^ 1);
        __syncthreads();
    }
#undef SW_LOAD_TILE
#undef SW_WRITE_TILE
    const float inv = 1.f / (xor32_add(ls, lane) + __builtin_amdgcn_exp2f(sinkl2 - Mx));
#pragma unroll
    for (int dt = 0; dt < 2; ++dt)
#pragma unroll
        for (int g4 = 0; g4 < 4; ++g4) { const int dv0 = dt * 32 + 8 * g4 + 4 * hh;
            v2u o; o.x = pk2(O[dt][4 * g4] * inv, O[dt][4 * g4 + 1] * inv); o.y = pk2(O[dt][4 * g4 + 2] * inv, O[dt][4 * g4 + 3] * inv);
            *(GAS v2u*)(mix + (size_t)qrow * DM + 768 + (kv * 2 + g) * 64 + dv0) = o; }
}

constexpr int NSLOT = 24, S_N1 = 0, S_G1 = 1, S_PREP = 2, S_MIX = 3, S_HP = 4, S_G2 = 5, S_N2 = 6, S_MCV = 7, S_F = 8;
constexpr int NPHASES = 1 + DEPTH * NSLOT;
#define WGM_G1 16
#define WGM_F1 4
#define WGM_N1K 4
#ifndef DUP_MASK
#define DUP_MASK 0
#endif
#define DUPN(k) ((((DUP_MASK) >> (k)) & 1) + 1)
#ifndef MK_SINGLE
#define MK_SINGLE 1
#endif
struct Args { const float* in[24]; float* out; unsigned char* ws; int ph_lo, ph_hi, li, pad; };
#define WSB(off) ((bf16*)(WSP() + (off)))
#define WSF(off) ((float*)(WSP() + (off)))
__global__ void __launch_bounds__(NTHREADS, 2) mk_fwd(Args args) {
    extern __shared__ __attribute__((aligned(16))) unsigned char lds[];
    Frame F;
    F.lds = (LAS unsigned char*)lds; F.MISC = (volatile LAS unsigned*)(F.lds + LDSCTL_OFF);
    F.tid = threadIdx.x; F.lane = F.tid & 63; F.wave = __builtin_amdgcn_readfirstlane(F.tid >> 6);
    F.G = gridDim.x; { const int bx = blockIdx.x; F.vcu = (F.G % 8 == 0) ? (bx % 8) * (F.G / 8) + bx / 8 : bx; }
    for (int u = F.tid; u < (LDS_BYTES - LDSCTL_OFF) / 4; u += NTHREADS) ((LAS unsigned*)(F.lds + LDSCTL_OFF))[u] = 0u;
    __syncthreads();
    if (F.tid == 0) { volatile LAS unsigned long long* pt = (volatile LAS unsigned long long*)(F.lds + PTR_OFF);
#pragma unroll
        for (int i = 0; i < 24; ++i) pt[i] = (unsigned long long)args.in[i];
        pt[24] = (unsigned long long)args.out; pt[25] = (unsigned long long)args.ws; }
    __syncthreads();
    const int lo = args.ph_lo, hi = args.ph_hi;
    XcdBarrier bar; bar.bar = (unsigned*)(args.ws + WS_CTL) + CW_BAR; bar.x = 0; bar.st = nullptr;
    if (hi - lo > 1) bar = xcd_barrier_post((unsigned*)(args.ws + WS_CTL) + CW_BAR, F.MISC + 8);
    bool ran = false;
#define PH(id) if (lo <= (id) && (id) < hi)
#define REFRESH() do { int tz_ = threadIdx.x; asm volatile("" : "+v"(tz_)); F.tid = tz_; F.lane = tz_ & 63; F.wave = __builtin_amdgcn_readfirstlane(tz_ >> 6); } while (0)
#define SEAM() do { if (ran) { XcdBarrier b2_; b2_.bar = (unsigned*)(WSP() + WS_CTL) + CW_BAR; b2_.x = bar.x; b2_.st = bar.st; xcd_barrier(b2_); if (DUPN(7) > 1) xcd_barrier(b2_); } ran = true; int tz_ = threadIdx.x; asm volatile("" : "+v"(tz_)); F.tid = tz_; F.lane = tz_ & 63; F.wave = __builtin_amdgcn_readfirstlane(tz_ >> 6); } while (0)

    PH(0) { SEAM();
        for (int rep = 0; rep < DUPN(12); ++rep) {
        for (int rep2 = 0; rep2 < DUPN(13); ++rep2)
        mod_partial(F, INP(1), INP(3), INP(4), WSF(WS_BIG));
        for (int rep3 = 0; rep3 < DUPN(14); ++rep3) {
        LAS float* scr = (LAS float*)(F.lds + F.wave * 16640); int base = 0;
        for (int l = 0; l < DEPTH; ++l) tr_matrix(F, INP(8) + (size_t)l * DM * DIN, DM, DIN, WSB(WS_WINT) + (size_t)l * DIN * DM, 3, base, scr);
        for (int l = 0; l < DEPTH; ++l) tr_matrix(F, INP(9) + (size_t)l * DM * DM, DM, DM, WSB(WS_WOUTT) + (size_t)l * DM * DM, 0, base, scr);
        for (int j = 0; j < 2; ++j) { tr_matrix(F, INP(17) + (size_t)j * DM * DFF, DM, DFF, WSB(WS_W13T) + (size_t)j * 2 * DFF * DM, 1, base, scr);
            tr_matrix(F, INP(18) + (size_t)j * DM * DFF, DM, DFF, WSB(WS_W13T) + (size_t)j * 2 * DFF * DM, 2, base, scr);
            tr_matrix(F, INP(19) + (size_t)j * DFF * DM, DFF, DM, WSB(WS_W2T) + (size_t)j * DM * DFF, 0, base, scr); }
        __syncthreads(); }
        __syncthreads(); }
    }
    if (lo <= 0 && 0 < hi) { SEAM(); mod_finalize(F, WSF(WS_BIG), INP(5), WSF(WS_MOD), WSB(WS_SBF)); }
    for (int L = 0; L < DEPTH; ++L) {
        const int pb = 1 + L * NSLOT;
        if (pb + NSLOT <= lo || pb >= hi) continue;
        const bool need_ctx = L < DEPTH - 1; const int rows_post = need_ctx ? M_ALL : M_LAT;
#define XBL() (WSB(WS_XB))
#define XBC() (WSB(WS_XB) + (size_t)M_LAT * DM)
#define MODL() (WSF(WS_MOD) + (size_t)L * 33 * 6144)
        if (L == 0) PH(pb + S_N1) { SEAM();
            { float* GSC = WSF(WS_GSC); const float* MOD = WSF(WS_MOD); const float* gm = INP(6); const float* gf = INP(7);
#pragma unroll 1
              for (int i = F.vcu * NTHREADS + F.tid; i < 5 * 33 * 1024; i += F.G * NTHREADS) { const int t = i / (33 * 1024), rr = (i / 1024) % 33, cc = i & 1023; const int Lx = t < 3 ? t + 1 : 2 * (t - 3);
                  GSC[i] = (t < 3 ? gm[Lx * 1024 + cc] : gf[Lx * 1024 + cc]) * (1.f + MOD[((size_t)Lx * 33 + rr) * 6144 + (t < 3 ? 1024 : 4096) + cc]); } }
            for (int t = 0; t < 5; ++t) {
                const bool f1 = t >= 3; const int N = f1 ? 2 * DFF : DIN, off = f1 ? 45 + 22 * (t - 3) : 15 * t;
                pg8::Gemm g{WSB(WS_SBF) + (size_t)t * 256 * DM, f1 ? WSB(WS_W13T) + (size_t)(t - 3) * 2 * DFF * DM : WSB(WS_WINT) + (size_t)(t + 1) * DIN * DM, 256, N, DM};
                pg8::StaticOrder S; S.init(256, N, F.G, (int)((blockIdx.x + F.G - off) % F.G));
                pg8::EpiBias E{f1 ? WSF(WS_BF1) + (size_t)(2 * (t - 3)) * 33 * DFF : WSF(WS_BG1) + (size_t)t * 33 * DIN, WSF(WS_BF1) + (size_t)(2 * (t - 3) + 1) * 33 * DFF, f1 ? DFF : DIN, f1 ? 1 : 0};
                pg8::gemm_phase<pg8::EpiBias, pg8::StaticOrder, true, true>(F.lds + RING_OFF, g, S, E); }
            REFRESH();
            for (int rep = 0; rep < DUPN(0); ++rep) norm_phase<false, true>(F, INP(0), INP(2), XBL(), M_ALL, INP(6) + L * DM, MODL(), 0, 1, ACTP(), nullptr, nullptr, nullptr, nullptr); }
        PH(pb + S_G1) { SEAM();
            pg8::Gemm g{ACTP(), WSB(WS_WINT) + (size_t)L * DIN * DM, M_ALL, DIN, DM}; pg8::StaticOrder S; S.init(M_ALL, DIN, F.G, (int)blockIdx.x, WGM_G1);
            pg8::EpiStoreBf16 E{WSB(WS_BIG), DIN, L > 0 ? WSF(WS_SSP) : nullptr, WSF(WS_BG1) + (size_t)(L > 0 ? L - 1 : 0) * 33 * DIN, INP(10) + L * 64, INP(15) + L * 128, F.lane};
            for (int rep = 0; rep < DUPN(1); ++rep) pg8::gemm_phase<pg8::EpiStoreBf16, pg8::StaticOrder, true, true>(F.lds + RING_OFF, g, S, E); }
        PH(pb + S_MIX) { SEAM();
            const float lam_init = 0.8f - 0.6f * expf(-0.3f * (float)L);
            float lam, bound_da, bound_sw;
            { const int ln = F.lane; const float* lv = INP(11) + L * 128;
              const float d0 = wave_sum(ln < 32 ? lv[ln] * lv[32 + ln] : 0.f, ln), d1 = wave_sum(ln < 32 ? lv[64 + ln] * lv[96 + ln] : 0.f, ln);
              lam = expf(d0) - expf(d1) + lam_init;
              const float* g1 = INP(10) + L * 64; const float a1 = fabsf(g1[ln]);
              bound_da = 5.656854249f * 1.4426950409f * wave_max(ln < 32 ? a1 : 0.f, ln) * wave_max(ln >= 32 ? a1 : 0.f, ln);
              const float* g2 = INP(15) + L * 128;
              bound_sw = 8.f * 1.4426950409f * wave_max(fabsf(g2[ln]), ln) * wave_max(fabsf(g2[64 + ln]), ln); }
            for (int rep = 0; rep < DUPN(11); ++rep)
            for (int i = F.vcu; i < 256; i += F.G) hgrn_item(F, WSB(WS_BIG), i >> 3, (i >> 1) & 3, i & 1, INP(13), L, rep == DUPN(11) - 1);
            const int n_lat = 1024, n_it = n_lat + (need_ctx ? 128 : 0);
            REFRESH();
            for (int rep = 0; rep < DUPN(2); ++rep)
#pragma unroll 1
            for (int i = F.vcu; i < n_it; i += F.G) { const bool cq = i >= n_lat; const int j = i - n_lat;
                da_item(F, WSB(WS_BIG), ACTP(), cq ? (j >> 2) : (i >> 5), cq ? (j & 3) : ((i >> 3) & 3), cq ? 0 : (i & 7) * 256, cq, lam, lam_init, bound_da, INP(12) + L * 64); }
            REFRESH();
            for (int rep = 0; rep < DUPN(3); ++rep)
#pragma unroll 1
            for (int i = F.vcu; i < n_it; i += F.G) { const bool cq = i >= n_lat; const int j = i - n_lat;
                sw_item(F, WSB(WS_BIG), ACTP(), cq ? (j >> 2) : (i >> 5), cq ? ((j >> 1) & 1) : ((i >> 4) & 1), cq ? (j & 1) * 128 : (i & 15) * 128, cq, INP(16) + L * 4, bound_sw); }
        }
        PH(pb + S_HP) { SEAM(); for (int rep = 0; rep < DUPN(4); ++rep) hgrn_post_phase(F, WSB(WS_BIG), ACTP(), INP(14) + L * 128, rows_post); }
        PH(pb + S_G2) { SEAM();
            pg8::Gemm g{ACTP(), WSB(WS_WOUTT) + (size_t)L * DM * DM, rows_post, DM, DM}; pg8::StaticOrder S; S.init(rows_post, DM, F.G, (int)blockIdx.x, WGM_N1K);
            const bool dn = !(L & 1);
            pg8::EpiRes E{XBL(), XBL(), XBC(), XBC(), MODL() + 2 * DM, dn ? WSB(WS_ACT2) : nullptr, WSF(WS_GSC) + (size_t)(3 + (L >> 1)) * 33 * DM, WSF(WS_SSP), F.lane, (LAS float*)(F.lds + RING_BYTES)};
            pg8::gemm_phase<pg8::EpiRes, pg8::StaticOrder, true, true>(F.lds + RING_OFF, g, S, E); }
        if (L & 1) PH(pb + S_N2) { SEAM();
            for (int rep = 0; rep < DUPN(5); ++rep)
            norm_phase<true, false>(F, XBL(), XBC(), nullptr, rows_post, INP(7) + L * DM, MODL(), 3, 4, ACTP(), INP(20) + (size_t)(L >> 1) * DM * NEXP, (int*)WSF(WS_ROWINFO), (int*)WSF(WS_CNT), (int*)WSF(WS_TOK)); }
        if (!(L & 1)) {
            PH(pb + S_F) { SEAM();
                pg8::Gemm g{WSB(WS_ACT2), WSB(WS_W13T) + (size_t)(L >> 1) * 2 * DFF * DM, rows_post, 2 * DFF, DM}; pg8::StaticOrder S; S.init(rows_post, 2 * DFF, F.G, (int)blockIdx.x, WGM_F1);
                pg8::EpiSwiglu E{WSB(WS_BIG), DFF, WSF(WS_SSP), WSF(WS_BF1) + (size_t)(2 * (L >> 1)) * 33 * DFF, WSF(WS_BF1) + (size_t)(2 * (L >> 1) + 1) * 33 * DFF};
                for (int rep = 0; rep < DUPN(8); ++rep) pg8::gemm_phase<pg8::EpiSwiglu, pg8::StaticOrder, true, true>(F.lds + RING_OFF, g, S, E); }
            PH(pb + S_F + 1) { SEAM();
                pg8::Gemm g{WSB(WS_BIG), WSB(WS_W2T) + (size_t)(L >> 1) * DM * DFF, rows_post, DM, DFF}; pg8::StaticOrder S; S.init(rows_post, DM, F.G, (int)blockIdx.x, WGM_N1K);
                pg8::EpiRes E{XBL(), XBL(), XBC(), XBC(), MODL() + 5 * DM, ACTP(), WSF(WS_GSC) + (size_t)L * 33 * DM, WSF(WS_SSP), F.lane, (LAS float*)(F.lds + RING_BYTES)};
                pg8::gemm_phase<pg8::EpiRes, pg8::StaticOrder, true, true>(F.lds + RING_OFF, g, S, E); }
        } else {
            PH(pb + S_MCV) { SEAM();
                for (int rep = 0; rep < DUPN(10); ++rep) {
                LAS float* scr = (LAS float*)(F.lds + F.wave * 16640); int base = 0;
                for (int e = 0; e < NEXP; ++e) { const size_t eo = ((size_t)(L >> 1) * NEXP + e) * DM * DFF;
                    tr_matrix(F, INP(21) + eo, DM, DFF, WSB(WS_MW13T) + (size_t)e * 2 * DFF * DM, 1, base, scr);
                    tr_matrix(F, INP(22) + eo, DM, DFF, WSB(WS_MW13T) + (size_t)e * 2 * DFF * DM, 2, base, scr);
                    tr_matrix(F, INP(23) + eo, DFF, DM, WSB(WS_MW2T) + (size_t)e * DM * DFF, 0, base, scr); }
                moe_setup(F, (const int*)WSF(WS_CNT));
                moe_gather(F, 0, rows_post, ACTP(), WSB(WS_BIG), (const int*)WSF(WS_ROWINFO), (int*)WSF(WS_TOK), WSF(WS_WGT)); __syncthreads(); } }
            for (int st = 0; st < 2; ++st) {
                PH(pb + S_F + 2 * st) { SEAM();
                    moe_setup(F, (const int*)WSF(WS_CNT));
                    const volatile LAS int* segt = (const volatile LAS int*)(F.lds + SEGT_OFF) + st * 9; const int mp = __builtin_amdgcn_readfirstlane(segt[8]) * 256;
                    pg8::Gemm g{ACTP(), WSB(WS_MW13T), mp, 2 * DFF, DM}; pg8::GatherOrder S; S.init(mp, 2 * DFF, F.G, (int)blockIdx.x, WGM_F1); S.segt = segt; S.estride = (size_t)2 * DFF * DM * 2; S.tok = (const int*)WSF(WS_TOK) + st * MOE_MAXR;
                    pg8::EpiSwiglu E{WSB(WS_HIDM), DFF, nullptr, nullptr, nullptr};
                    for (int rep = 0; rep < DUPN(9); ++rep) pg8::gemm_phase<pg8::EpiSwiglu, pg8::GatherOrder, true, true>(F.lds + RING_OFF, g, S, E); }
                PH(pb + S_F + 2 * st + 1) { SEAM();
                    moe_setup(F, (const int*)WSF(WS_CNT));
                    if (st == 0) moe_gather(F, 1, rows_post, ACTP(), WSB(WS_BIG), (const int*)WSF(WS_ROWINFO), (int*)WSF(WS_TOK), WSF(WS_WGT));
                    __syncthreads();
                    const volatile LAS int* segt = (const volatile LAS int*)(F.lds + SEGT_OFF) + st * 9; const int mp = __builtin_amdgcn_readfirstlane(segt[8]) * 256;
                    pg8::Gemm g{WSB(WS_HIDM), WSB(WS_MW2T), mp, DM, DFF}; pg8::GroupedOrder S; S.init(mp, DM, F.G, (int)blockIdx.x, WGM_N1K); S.segt = segt; S.estride = (size_t)DM * DFF * 2;
                    pg8::EpiMoeRes E{XBL(), XBC(), MODL() + 5 * DM, (const int*)WSF(WS_TOK) + st * MOE_MAXR, WSF(WS_WGT) + st * MOE_MAXR, (st == 1 && need_ctx) ? ACTP() : nullptr, WSF(WS_GSC) + (size_t)L * 33 * DM, WSF(WS_SSP), F.lane, (LAS float*)(F.lds + RING_BYTES), st == 0 ? WSB(WS_BIG) : nullptr, st == 0 ? nullptr : WSB(WS_BIG), (st == 1 && !need_ctx) ? OUTP() : nullptr};
                    pg8::gemm_phase<pg8::EpiMoeRes, pg8::GroupedOrder, true, true>(F.lds + RING_OFF, g, S, E); }
            }
        }
    }
#undef PH
#undef SEAM
}

extern "C" void kernel_launch(void* const* d_in, const int* in_sizes, int n_in, void* d_out, int out_size, void* d_ws, size_t ws_size, hipStream_t stream) {
    static int grid = 0;
    if (grid == 0) {
        if (n_in != 24 || in_sizes[0] != M_LAT * DM || out_size != M_LAT * DM || ws_size < WS_END) { fprintf(stderr, "kernel_launch: unexpected shapes (n_in %d, in0 %d, out %d, ws %zu); nothing launched\n", n_in, n_in > 0 ? in_sizes[0] : -1, out_size, ws_size); grid = -1; return; }
        int dev = 0, cus = 0, per_cu = 0;
        if (hipGetDevice(&dev) != hipSuccess || hipDeviceGetAttribute(&cus, hipDeviceAttributeMultiprocessorCount, dev) != hipSuccess) { grid = -1; return; }
        if (hipFuncSetAttribute((const void*)mk_fwd, hipFuncAttributeMaxDynamicSharedMemorySize, LDS_BYTES) != hipSuccess) { fprintf(stderr, "kernel_launch: hipFuncSetAttribute failed\n"); grid = -1; return; }
        if (hipOccupancyMaxActiveBlocksPerMultiprocessor(&per_cu, (const void*)mk_fwd, NTHREADS, LDS_BYTES) != hipSuccess || per_cu < 1) fprintf(stderr, "kernel_launch: occupancy query reports %d\n", per_cu);
        (void)hipGetLastError();
        grid = cus;
    }
    if (grid < 0) return;
    if (hipMemsetAsync((char*)d_ws + WS_CTL, 0, CTL_ZERO_BYTES, stream) != hipSuccess) return;
    Args a{};
    for (int i = 0; i < 24; ++i) a.in[i] = (const float*)d_in[i];
    a.out = (float*)d_out; a.ws = (unsigned char*)d_ws; a.pad = 0;
#if MK_SINGLE
    a.ph_lo = 0; a.ph_hi = NPHASES; a.li = 0;
    hipLaunchKernelGGL(mk_fwd, dim3(grid), dim3(NTHREADS), LDS_BYTES, stream, a);
#else
    int li = 0;
    for (int p = 0; p < NPHASES; ++p) {
        if (p > 0) { const int L = (p - 1) / NSLOT, s = (p - 1) % NSLOT; const bool moe = L & 1;
            if (!moe && (s == S_MCV || s >= S_F + 2 || s == S_N2)) continue; if (moe && s >= S_F + 4) continue; if (L > 0 && s == S_N1) continue; }
        a.ph_lo = p; a.ph_hi = p + 1; a.li = 0; ++li;
        hipLaunchKernelGGL(mk_fwd, dim3(grid), dim3(NTHREADS), LDS_BYTES, stream, a);
    }
#endif
}
```

```cpp
#include <hip/hip_runtime.h>
#include <cstdio>
#include <cstdint>
namespace pg8 {
#define PG8_LAS __attribute__((address_space(3)))
#define PG8_GAS __attribute__((address_space(1)))
typedef unsigned short bf16_t;
typedef short bf16x8 __attribute__((ext_vector_type(8)));
typedef float f32x4 __attribute__((ext_vector_type(4)));
typedef unsigned u32x4 __attribute__((ext_vector_type(4)));
constexpr int BM = 256, BK = 64, HALF = 128, HTB = HALF * BK * 2  , STAGE_BYTES = 8 * HTB, NXCD = 8, WGM = 8;

__host__ __device__ __forceinline__ int lds_byte(int r, int c) { const int st = (r >> 4) * 2 + (c >> 5), rr = r & 15, cc = c & 31, ob = rr * 64 + cc * 2; return st * 1024 + (ob ^ (((ob >> 9) & 1) << 5)); }
__host__ __device__ __forceinline__ void stage_rc(int b, int& R, int& C) { const int st = b / 1024, sb = b % 1024, swz = sb ^ (((sb >> 9) & 1) << 5); R = (st >> 1) * 16 + swz / 64; C = (st & 1) * 32 + (swz % 64) / 2; }
__host__ __device__ __forceinline__ int perm32(int rho) { const int n = rho >> 4, i = rho & 15; return 8 * (i >> 2) + 4 * n + (i & 3); }

struct Unit { int pm, pn; };
struct Gemm { const bf16_t* A; const bf16_t* Bt; int M, N, K; };

struct StaticOrder {
    int nM, nN, nwg, G, c, wgm;
    __host__ __device__ void init(int M, int N, int G_, int c_, int wgm_ = WGM) { nM = M / BM; nN = N / BM; nwg = nM * nN; G = G_; c = c_; wgm = wgm_; }
    __host__ __device__ bool next(int i, Unit& u) const {
        const long L = (long)i * G + c; if (L >= nwg) return false;
        int wgid = (int)L; { const int q = nwg / NXCD, r = nwg % NXCD, xcd = wgid % NXCD, off = wgid / NXCD; wgid = (xcd < r ? xcd * (q + 1) : r * (q + 1) + (xcd - r) * q) + off; }
        const int nig = wgm * nN, gid = wgid / nig, fm = gid * wgm, gsz = (nM - fm) < wgm ? (nM - fm) : wgm;
        u.pm = fm + ((wgid % nig) % gsz); u.pn = (wgid % nig) / gsz; return true;
    }
    __device__ __forceinline__ void a_ready(const Unit&) const {}
    __device__ __forceinline__ void done(const Unit&) const {}
    __device__ __forceinline__ size_t boff(const Unit&) const { return 0; }
    static constexpr bool GATHER = false;
    __device__ __forceinline__ const int* rowidx() const { return nullptr; }
};
struct GroupedOrder : StaticOrder {
    const volatile PG8_LAS int* segt; size_t estride;
    __device__ __forceinline__ size_t boff(const Unit& u) const { int e = 0;
#pragma unroll
        for (int k = 1; k < 8; ++k) e += (u.pm >= __builtin_amdgcn_readfirstlane(segt[k])) ? 1 : 0;
        return (size_t)e * estride; }
};
struct GatherOrder : GroupedOrder {
    const int* tok;
    static constexpr bool GATHER = true;
    __device__ __forceinline__ const int* rowidx() const { return tok; }
};

__device__ __forceinline__ unsigned cvt_pk_bf16(float lo, float hi) { unsigned r; asm volatile("v_cvt_pk_bf16_f32 %0, %1, %2" : "=v"(r) : "v"(lo), "v"(hi)); return r; }
__device__ __forceinline__ float silu_f(float a) { return a * __builtin_amdgcn_rcpf(1.f + __expf(-a)); }
__device__ __forceinline__ float dn_rstd(const float* ssp, int row) { const f32x4 a = *(const PG8_GAS f32x4*)(ssp + (size_t)row * 4); return __builtin_amdgcn_rsqf(((a[0] + a[1]) + (a[2] + a[3])) * (1.f / 1024.f) + 1e-6f); }
struct EpiStoreBf16 {
    static constexpr bool PERM = true, AFTER_DRAIN = false;
    bf16_t* O; int ldc; const float* ssp; const float* bias; const float* dqk; const float* sqk; int lane;
    __device__ __forceinline__ void operator()(const f32x4 (&acc)[2][2][4][2], const Unit& u, int wr, int wc, int fr, int fq) const {
        const int row0 = u.pm * BM + wr * 64 + fr, col0 = u.pn * BM + wc * 32 + 8 * fq;
        f32x4 bv[2][2];
        if (ssp) { const float* bp = bias + (size_t)(u.pm < 256 ? (u.pm >> 3) : 32) * ldc + col0;
#pragma unroll
            for (int bj = 0; bj < 2; ++bj) { bv[bj][0] = *(const PG8_GAS f32x4*)(bp + bj * HALF); bv[bj][1] = *(const PG8_GAS f32x4*)(bp + bj * HALF + 4); } }
        float rsv[2][4];
#pragma unroll
        for (int ai = 0; ai < 2; ++ai)
#pragma unroll
            for (int m = 0; m < 4; ++m) rsv[ai][m] = 1.f;
        if (ssp) { f32x4 sv[2][4];
#pragma unroll
            for (int ai = 0; ai < 2; ++ai)
#pragma unroll
                for (int m = 0; m < 4; ++m) sv[ai][m] = *(const PG8_GAS f32x4*)(ssp + (size_t)(row0 + ai * HALF + m * 16) * 4);
#pragma unroll
            for (int ai = 0; ai < 2; ++ai)
#pragma unroll
                for (int m = 0; m < 4; ++m) rsv[ai][m] = __builtin_amdgcn_rsqf(((sv[ai][m][0] + sv[ai][m][1]) + (sv[ai][m][2] + sv[ai][m][3])) * (1.f / 1024.f) + 1e-6f); }
#define PG8_RS(ai_, m_) rsv[ai_][m_]
        const bool tileA = u.pn < 2, tileC = u.pn >= 13, qk = tileA || (tileC && (u.pn == 13 || wc < 2));
        if (!tileA && !tileC) {
            const bool hq = (u.pn == 3) || (u.pn == 4);
#pragma unroll
            for (int ai = 0; ai < 2; ++ai)
#pragma unroll
                for (int m = 0; m < 4; ++m) { const int row = row0 + ai * HALF + m * 16; bf16_t* rowp = O + (size_t)row * ldc + u.pn * BM + 64 * wc + 8 * fq;
                    const float rs = PG8_RS(ai, m);
#pragma unroll
                    for (int bj = 0; bj < 2; ++bj) { f32x4 v0 = acc[ai][bj][m][0], v1 = acc[ai][bj][m][1];
                        if (ssp) { v0 = v0 * rs + bv[bj][0]; v1 = v1 * rs + bv[bj][1]; }
                        if (hq) { v0[0] = silu_f(v0[0]); v0[1] = silu_f(v0[1]); v0[2] = silu_f(v0[2]); v0[3] = silu_f(v0[3]); v1[0] = silu_f(v1[0]); v1[1] = silu_f(v1[1]); v1[2] = silu_f(v1[2]); v1[3] = silu_f(v1[3]); }
                        u32x4 o; o.x = cvt_pk_bf16(v0[0], v0[1]); o.y = cvt_pk_bf16(v0[2], v0[3]); o.z = cvt_pk_bf16(v1[0], v1[1]); o.w = cvt_pk_bf16(v1[2], v1[3]);
                        *(PG8_GAS u32x4*)(rowp + bj * 32) = o; } }
            return; }
        const bool lat = u.pm < 256;
        float gn[2][2][4], inv[4];
        const float scale = (u.pn == 0) ? 0.25503486f : (u.pn == 13 ? 0.18033688f : 1.f);
        if (tileA) { const float* g = dqk + u.pn * 32 + ((fq >> 1) * 16 + (fq & 1) * 4);
#pragma unroll
            for (int n = 0; n < 2; ++n)
#pragma unroll
                for (int j = 0; j < 4; ++j) { const float gv = *(const PG8_GAS float*)(g + 8 * n + j); gn[0][n][j] = gv; gn[1][n][j] = gv; }
#pragma unroll
            for (int j = 0; j < 4; ++j) inv[j] = __builtin_amdgcn_exp2f(-(float)(4 * (fq & 1) + j) * (13.287712379549449f / 8.f)); }
        else { const float* g = sqk + (u.pn == 13 ? 0 : 64) + 4 * fq;
#pragma unroll
            for (int bj = 0; bj < 2; ++bj)
#pragma unroll
                for (int n = 0; n < 2; ++n)
#pragma unroll
                    for (int j = 0; j < 4; ++j) gn[bj][n][j] = qk ? *(const PG8_GAS float*)(g + 32 * bj + 16 * n + j) : 1.f;
#pragma unroll
            for (int j = 0; j < 4; ++j) inv[j] = __builtin_amdgcn_exp2f(-(float)(4 * fq + j) * (13.287712379549449f / 16.f)); }
        int scol[2][2];
#pragma unroll
        for (int bj = 0; bj < 2; ++bj)
#pragma unroll
            for (int n = 0; n < 2; ++n) scol[bj][n] = tileA ? u.pn * BM + (4 * bj + wc) * 32 + (fq >> 1) * 16 + (fq & 1) * 4 + 8 * n : u.pn * BM + 64 * wc + 32 * bj + 16 * n + 4 * fq;
#pragma unroll
        for (int ai = 0; ai < 2; ++ai)
#pragma unroll
            for (int m = 0; m < 4; ++m) { const int row = row0 + ai * HALF + m * 16; bf16_t* rowp = O + (size_t)row * ldc;
                const float rs = PG8_RS(ai, m);
                f32x4 v[2][2];
#pragma unroll
                for (int bj = 0; bj < 2; ++bj)
#pragma unroll
                    for (int n = 0; n < 2; ++n) { v[bj][n] = acc[ai][bj][m][n]; if (ssp) v[bj][n] = v[bj][n] * rs + bv[bj][n]; }
                if (qk) {
                    float s0 = 0.f, s1 = 0.f;
#pragma unroll
                    for (int n = 0; n < 2; ++n) { s0 += (v[0][n][0] * v[0][n][0] + v[0][n][1] * v[0][n][1]) + (v[0][n][2] * v[0][n][2] + v[0][n][3] * v[0][n][3]); s1 += (v[1][n][0] * v[1][n][0] + v[1][n][1] * v[1][n][1]) + (v[1][n][2] * v[1][n][2] + v[1][n][3] * v[1][n][3]); }
                    if (!tileA) { s0 += s1; s1 = s0; }
                    s0 += __builtin_bit_cast(float, __builtin_amdgcn_ds_bpermute((lane ^ 16) << 2, __builtin_bit_cast(int, s0))); s0 += __builtin_bit_cast(float, __builtin_amdgcn_ds_bpermute((lane ^ 32) << 2, __builtin_bit_cast(int, s0)));
                    if (tileA) { s1 += __builtin_bit_cast(float, __builtin_amdgcn_ds_bpermute((lane ^ 16) << 2, __builtin_bit_cast(int, s1))); s1 += __builtin_bit_cast(float, __builtin_amdgcn_ds_bpermute((lane ^ 32) << 2, __builtin_bit_cast(int, s1))); } else s1 = s0;
                    const float nd = tileA ? (1.f / 32.f) : (1.f / 64.f);
                    const float r0 = __builtin_amdgcn_rsqf(s0 * nd + 1e-6f), r1 = __builtin_amdgcn_rsqf(s1 * nd + 1e-6f);
#pragma unroll
                    for (int n = 0; n < 2; ++n)
#pragma unroll
                        for (int j = 0; j < 4; ++j) { v[0][n][j] = v[0][n][j] * r0 * gn[0][n][j]; v[1][n][j] = v[1][n][j] * r1 * gn[1][n][j]; }
                    if (lat) { const int t = row & 2047; const float prow = (float)(t >> 6), pcol = (float)(t & 63);
#pragma unroll
                        for (int bj = 0; bj < 2; ++bj) { const float pos = tileA ? (fq < 2 ? prow : pcol) : (bj ? pcol : prow);
#pragma unroll
                            for (int j = 0; j < 4; ++j) { const float a = pos * inv[j], cs = __cosf(a), sn = __sinf(a), x1 = v[bj][0][j], x2 = v[bj][1][j]; v[bj][0][j] = x1 * cs - x2 * sn; v[bj][1][j] = x1 * sn + x2 * cs; } } }
#pragma unroll
                    for (int bj = 0; bj < 2; ++bj)
#pragma unroll
                        for (int n = 0; n < 2; ++n) v[bj][n] = v[bj][n] * scale;
                }
#pragma unroll
                for (int bj = 0; bj < 2; ++bj)
#pragma unroll
                    for (int n = 0; n < 2; ++n) { const unsigned lo = cvt_pk_bf16(v[bj][n][0], v[bj][n][1]), hi = cvt_pk_bf16(v[bj][n][2], v[bj][n][3]);
                        *(PG8_GAS unsigned long long*)(rowp + scol[bj][n]) = (unsigned long long)lo | ((unsigned long long)hi << 32); } }
    }
};
struct EpiSwiglu {
    static constexpr bool PERM = true, AFTER_DRAIN = false;
    bf16_t* O; int ldc; const float* ssp; const float* bias1; const float* bias3;
    __device__ __forceinline__ void operator()(const f32x4 (&acc)[2][2][4][2], const Unit& u, int wr, int wc, int fr, int fq) const {
        const int row0 = u.pm * BM + wr * 64 + fr, col0 = u.pn * HALF + wc * 32 + 8 * fq;
        f32x4 b1[2], b3[2];
        if (ssp) { const size_t bo = (size_t)(u.pm < 256 ? (u.pm >> 3) : 32) * ldc + col0;
            b1[0] = *(const PG8_GAS f32x4*)(bias1 + bo); b1[1] = *(const PG8_GAS f32x4*)(bias1 + bo + 4); b3[0] = *(const PG8_GAS f32x4*)(bias3 + bo); b3[1] = *(const PG8_GAS f32x4*)(bias3 + bo + 4); }
        float rsv[2][4];
        if (ssp) { f32x4 sv[2][4];
#pragma unroll
            for (int ai = 0; ai < 2; ++ai)
#pragma unroll
                for (int m = 0; m < 4; ++m) sv[ai][m] = *(const PG8_GAS f32x4*)(ssp + (size_t)(row0 + ai * HALF + m * 16) * 4);
#pragma unroll
            for (int ai = 0; ai < 2; ++ai)
#pragma unroll
                for (int m = 0; m < 4; ++m) rsv[ai][m] = __builtin_amdgcn_rsqf(((sv[ai][m][0] + sv[ai][m][1]) + (sv[ai][m][2] + sv[ai][m][3])) * (1.f / 1024.f) + 1e-6f); }
#pragma unroll
        for (int ai = 0; ai < 2; ++ai)
#pragma unroll
            for (int m = 0; m < 4; ++m) { const int row = row0 + ai * HALF + m * 16; bf16_t* rowp = O + (size_t)row * ldc + col0;
                f32x4 a0 = acc[ai][0][m][0], a1 = acc[ai][0][m][1], c0 = acc[ai][1][m][0], c1 = acc[ai][1][m][1];
                if (ssp) { const float rs = rsv[ai][m]; a0 = a0 * rs + b1[0]; a1 = a1 * rs + b1[1]; c0 = c0 * rs + b3[0]; c1 = c1 * rs + b3[1]; }
                u32x4 o; o.x = cvt_pk_bf16(silu_f(a0[0]) * c0[0], silu_f(a0[1]) * c0[1]); o.y = cvt_pk_bf16(silu_f(a0[2]) * c0[2], silu_f(a0[3]) * c0[3]);
                o.z = cvt_pk_bf16(silu_f(a1[0]) * c1[0], silu_f(a1[1]) * c1[1]); o.w = cvt_pk_bf16(silu_f(a1[2]) * c1[2], silu_f(a1[3]) * c1[3]);
                *(PG8_GAS u32x4*)rowp = o; }
    }
};
__device__ __forceinline__ void bf8_unpack(const u32x4 u, f32x4& a, f32x4& b) {
    a[0] = __builtin_bit_cast(float, u.x << 16); a[1] = __builtin_bit_cast(float, u.x & 0xffff0000u); a[2] = __builtin_bit_cast(float, u.y << 16); a[3] = __builtin_bit_cast(float, u.y & 0xffff0000u);
    b[0] = __builtin_bit_cast(float, u.z << 16); b[1] = __builtin_bit_cast(float, u.z & 0xffff0000u); b[2] = __builtin_bit_cast(float, u.w << 16); b[3] = __builtin_bit_cast(float, u.w & 0xffff0000u); }
__device__ __forceinline__ u32x4 bf8_pack(const f32x4& a, const f32x4& b) { u32x4 o; o.x = cvt_pk_bf16(a[0], a[1]); o.y = cvt_pk_bf16(a[2], a[3]); o.z = cvt_pk_bf16(b[0], b[1]); o.w = cvt_pk_bf16(b[2], b[3]); return o; }
struct EpiRes {
    static constexpr bool PERM = true, AFTER_DRAIN = false;
    const bf16_t* xin_l; bf16_t* xout_l; const bf16_t* xin_c; bf16_t* xout_c; const float* mod; bf16_t* nx; const float* gsc; float* ssp; int lane; PG8_LAS float* red;
    __device__ __forceinline__ void operator()(const f32x4 (&acc)[2][2][4][2], const Unit& u, int wr, int wc, int fr, int fq) const {
        const bool lat = u.pm < 256;
        const int rloc = (lat ? u.pm : u.pm - 256) * BM + wr * 64 + fr, col0 = u.pn * BM + wc * 32 + 8 * fq, bsel = lat ? (u.pm >> 3) : 32;
        const bf16_t* xin = lat ? xin_l : xin_c; bf16_t* xout = lat ? xout_l : xout_c;
        const float* md = mod + (size_t)bsel * 6144 + col0;
        f32x4 mv[2][2], gv[2][2];
#pragma unroll
        for (int bj = 0; bj < 2; ++bj)
#pragma unroll
            for (int n = 0; n < 2; ++n) { mv[bj][n] = *(const PG8_GAS f32x4*)(md + bj * HALF + n * 4); if (nx) gv[bj][n] = *(const PG8_GAS f32x4*)(gsc + (size_t)bsel * 1024 + col0 + bj * HALF + n * 4); }
#pragma unroll
        for (int ai = 0; ai < 2; ++ai) {
            u32x4 xv[4][2];
#pragma unroll
            for (int m = 0; m < 4; ++m)
#pragma unroll
                for (int bj = 0; bj < 2; ++bj) xv[m][bj] = *(const PG8_GAS u32x4*)(xin + (size_t)(rloc + ai * HALF + m * 16) * 1024 + col0 + bj * HALF);
#pragma unroll
            for (int m = 0; m < 4; ++m) { const size_t p = (size_t)(rloc + ai * HALF + m * 16) * 1024 + col0; const int urow = u.pm * BM + wr * 64 + fr + ai * HALF + m * 16;
                float ss = 0.f;
#pragma unroll
                for (int bj = 0; bj < 2; ++bj) { f32x4 x0, x1; bf8_unpack(xv[m][bj], x0, x1);
                    const f32x4 y0 = x0 + mv[bj][0] * acc[ai][bj][m][0], y1 = x1 + mv[bj][1] * acc[ai][bj][m][1];
                    *(PG8_GAS u32x4*)(xout + p + bj * HALF) = bf8_pack(y0, y1);
                    if (nx) { ss += ((y0[0] * y0[0] + y0[1] * y0[1]) + (y0[2] * y0[2] + y0[3] * y0[3])) + ((y1[0] * y1[0] + y1[1] * y1[1]) + (y1[2] * y1[2] + y1[3] * y1[3]));
                        *(PG8_GAS u32x4*)(nx + (size_t)urow * 1024 + col0 + bj * HALF) = bf8_pack(y0 * gv[bj][0], y1 * gv[bj][1]); } }
                if (nx) { ss += __builtin_bit_cast(float, __builtin_amdgcn_ds_bpermute((lane ^ 16) << 2, __builtin_bit_cast(int, ss))); ss += __builtin_bit_cast(float, __builtin_amdgcn_ds_bpermute((lane ^ 32) << 2, __builtin_bit_cast(int, ss)));
                    if (fq == 0) red[(wr * 64 + fr + ai * HALF + m * 16) * 4 + wc] = ss; } } }
        if (nx) { asm volatile("s_waitcnt lgkmcnt(0)" ::: "memory"); __builtin_amdgcn_s_barrier(); asm volatile("" ::: "memory");
            if (wc == 0 && fq == 0) {
#pragma unroll
                for (int ai = 0; ai < 2; ++ai)
#pragma unroll
                    for (int m = 0; m < 4; ++m) { const int rr = wr * 64 + fr + ai * HALF + m * 16; const f32x4 v = *(const PG8_LAS f32x4*)(red + rr * 4);
                        *(PG8_GAS float*)(ssp + (size_t)(u.pm * BM + rr) * 4 + u.pn) = (v[0] + v[1]) + (v[2] + v[3]); } }
            asm volatile("s_waitcnt lgkmcnt(0)" ::: "memory"); __builtin_amdgcn_s_barrier(); asm volatile("" ::: "memory"); }
    }
};
struct EpiMoeRes {
    static constexpr bool PERM = true, AFTER_DRAIN = false;
    bf16_t* x_l; bf16_t* x_c; const float* mod; const int* tok; const float* wgt; bf16_t* nx; const float* gsc; float* ssp; int lane; PG8_LAS float* red; bf16_t* y0w; const bf16_t* y0r; float* xfinal;
    __device__ __forceinline__ void operator()(const f32x4 (&acc)[2][2][4][2], const Unit& u, int wr, int wc, int fr, int fq) const {
        const int col0 = u.pn * BM + wc * 32 + 8 * fq;
        int tkv[2][4]; float wvv[2][4];
#pragma unroll
        for (int ai = 0; ai < 2; ++ai)
#pragma unroll
            for (int m = 0; m < 4; ++m) { const int pos = u.pm * BM + wr * 64 + fr + ai * HALF + m * 16; tkv[ai][m] = *(const PG8_GAS int*)(tok + pos); wvv[ai][m] = *(const PG8_GAS float*)(wgt + pos); }
        u32x4 xn[2], yn[2];
        xn[0] = xn[1] = yn[0] = yn[1] = (u32x4){0u, 0u, 0u, 0u};
#define MR_LOADXY(k_) do { const int t_ = tkv[(k_) >> 2][(k_) & 3]; if (!y0w && t_ >= 0) { const bf16_t* xp_ = ((t_ < 65536) ? x_l + (size_t)t_ * 1024 : x_c + (size_t)(t_ - 65536) * 1024) + col0; \
            _Pragma("unroll") for (int bj_ = 0; bj_ < 2; ++bj_) { xn[bj_] = *(const PG8_GAS u32x4*)(xp_ + bj_ * HALF); yn[bj_] = *(const PG8_GAS u32x4*)(y0r + (size_t)t_ * 1024 + col0 + bj_ * HALF); } } } while (0)
        MR_LOADXY(0);
#pragma unroll
        for (int k = 0; k < 8; ++k) { const int ai = k >> 2, m = k & 3; const int t = tkv[ai][m]; float ss = 0.f;
                const u32x4 xc[2] = {xn[0], xn[1]}, yc[2] = {yn[0], yn[1]};
                if (k + 1 < 8) MR_LOADXY(k + 1);
                if (t >= 0) { const float w = wvv[ai][m]; const bool lat = t < 65536; const int bsel = lat ? (t >> 11) : 32;
                    bf16_t* xp = (lat ? x_l + (size_t)t * 1024 : x_c + (size_t)(t - 65536) * 1024) + col0; const float* md = mod + (size_t)bsel * 6144 + col0;
#pragma unroll
                    for (int bj = 0; bj < 2; ++bj) { const f32x4 m0 = *(const PG8_GAS f32x4*)(md + bj * HALF), m1 = *(const PG8_GAS f32x4*)(md + bj * HALF + 4);
                        const f32x4 d0 = m0 * acc[ai][bj][m][0] * w, d1 = m1 * acc[ai][bj][m][1] * w;
                        if (y0w) { u32x4 o; o.x = cvt_pk_bf16(d0[0], d0[1]); o.y = cvt_pk_bf16(d0[2], d0[3]); o.z = cvt_pk_bf16(d1[0], d1[1]); o.w = cvt_pk_bf16(d1[2], d1[3]);
                            *(PG8_GAS u32x4*)(y0w + (size_t)t * 1024 + col0 + bj * HALF) = o; }
                        else { f32x4 x0, x1; bf8_unpack(xc[bj], x0, x1); const u32x4 yv = yc[bj];
                            f32x4 e0, e1; e0[0] = __builtin_bit_cast(float, yv.x << 16); e0[1] = __builtin_bit_cast(float, yv.x & 0xffff0000u); e0[2] = __builtin_bit_cast(float, yv.y << 16); e0[3] = __builtin_bit_cast(float, yv.y & 0xffff0000u);
                            e1[0] = __builtin_bit_cast(float, yv.z << 16); e1[1] = __builtin_bit_cast(float, yv.z & 0xffff0000u); e1[2] = __builtin_bit_cast(float, yv.w << 16); e1[3] = __builtin_bit_cast(float, yv.w & 0xffff0000u);
                            const f32x4 y0 = x0 + (e0 + d0), y1 = x1 + (e1 + d1);
                            if (xfinal) { float* fp = xfinal + (size_t)t * 1024 + col0 + bj * HALF; *(PG8_GAS f32x4*)fp = y0; *(PG8_GAS f32x4*)(fp + 4) = y1; } else *(PG8_GAS u32x4*)(xp + bj * HALF) = bf8_pack(y0, y1);
                            if (nx) { ss += ((y0[0] * y0[0] + y0[1] * y0[1]) + (y0[2] * y0[2] + y0[3] * y0[3])) + ((y1[0] * y1[0] + y1[1] * y1[1]) + (y1[2] * y1[2] + y1[3] * y1[3]));
                                const float* gp = gsc + (size_t)bsel * 1024 + col0 + bj * HALF; const f32x4 z0 = y0 * *(const PG8_GAS f32x4*)gp, z1 = y1 * *(const PG8_GAS f32x4*)(gp + 4);
                                u32x4 o; o.x = cvt_pk_bf16(z0[0], z0[1]); o.y = cvt_pk_bf16(z0[2], z0[3]); o.z = cvt_pk_bf16(z1[0], z1[1]); o.w = cvt_pk_bf16(z1[2], z1[3]);
                                *(PG8_GAS u32x4*)(nx + (size_t)t * 1024 + col0 + bj * HALF) = o; } } } }
                if (nx) { ss += __builtin_bit_cast(float, __builtin_amdgcn_ds_bpermute((lane ^ 16) << 2, __builtin_bit_cast(int, ss))); ss += __builtin_bit_cast(float, __builtin_amdgcn_ds_bpermute((lane ^ 32) << 2, __builtin_bit_cast(int, ss)));
                    if (fq == 0) red[(wr * 64 + fr + ai * HALF + m * 16) * 4 + wc] = ss; } }
        if (nx) { asm volatile("s_waitcnt lgkmcnt(0)" ::: "memory"); __builtin_amdgcn_s_barrier(); asm volatile("" ::: "memory");
            if (wc == 0 && fq == 0) {
#pragma unroll
                for (int ai = 0; ai < 2; ++ai)
#pragma unroll
                    for (int m = 0; m < 4; ++m) { const int rr = wr * 64 + fr + ai * HALF + m * 16; const int t = *(const PG8_GAS int*)(tok + u.pm * BM + rr); const f32x4 v = *(const PG8_LAS f32x4*)(red + rr * 4);
                        if (t >= 0) *(PG8_GAS float*)(ssp + (size_t)t * 4 + u.pn) = (v[0] + v[1]) + (v[2] + v[3]); } }
            asm volatile("s_waitcnt lgkmcnt(0)" ::: "memory"); __builtin_amdgcn_s_barrier(); asm volatile("" ::: "memory"); }
    }
};
struct EpiBias {
    static constexpr bool PERM = false, AFTER_DRAIN = false;
    float* out; float* out3; int ldo; int split;
    __device__ __forceinline__ void operator()(const f32x4 (&acc)[2][2][4][2], const Unit& u, int wr, int wc, int fr, int fq) const {
        if (wr != 0) return;
#pragma unroll
        for (int m = 0; m < 3; ++m) { const int row = m * 16 + fr; if (row < 33) {
#pragma unroll
            for (int bj = 0; bj < 2; ++bj)
#pragma unroll
                for (int n = 0; n < 2; ++n) { const int c = wc * 32 + n * 16 + 4 * fq;
                    if (split) *(PG8_GAS f32x4*)((bj ? out3 : out) + (size_t)row * ldo + u.pn * HALF + c) = acc[0][bj][m][n];
                    else *(PG8_GAS f32x4*)(out + (size_t)row * ldo + u.pn * BM + bj * HALF + c) = acc[0][bj][m][n]; } } }
    }
};
template <class Epi, class Sched, bool ALIGN_EPI = false, bool SP2 = false>
__device__ __forceinline__ void gemm_phase(PG8_LAS unsigned char* lds, const Gemm g, const Sched& S, const Epi& E) {
    int tid = threadIdx.x; asm volatile("" : "+v"(tid));
    const int wid = __builtin_amdgcn_readfirstlane(tid >> 6), lane = tid & 63, wr = wid >> 2, wc = wid & 3, fr = lane & 15, fq = lane >> 4;
    const int K = g.K, nt = K / BK;
    unsigned voffA[2], voffB[2];
#pragma unroll
    for (int i = 0; i < 2; ++i) { int R, C; stage_rc(tid * 16 + i * 8192, R, C); const int Rb = Epi::PERM ? ((R & ~31) + perm32(R & 31)) : R;
        voffA[i] = (unsigned)(R * K + C) * 2u; voffB[i] = (unsigned)(Rb * K + C) * 2u; }
    const size_t kstep = (size_t)(BK * 2);
    const size_t hstep = (size_t)HALF * K * 2;
    const size_t tstep = 2 * hstep;
    const unsigned ldsw = (unsigned)wid * 1024u;
    const int aoff = lds_byte(wr * 64 + fr, fq * 8), boff = lds_byte(wc * 32 + fr, fq * 8);
#define PG8_SA(b, h) (((b) * 2 + (h)) * HTB)
#define PG8_SB(b, h) ((4 + (b) * 2 + (h)) * HTB)
#define PG8_STAGE(bufoff, gbase, voff) do { _Pragma("unroll") for (int _i = 0; _i < 2; ++_i) \
        __builtin_amdgcn_global_load_lds((const unsigned*)((const char*)(gbase) + (voff)[_i]), (PG8_LAS unsigned*)(lds + (bufoff) + ldsw + _i * 8192), 16, 0, 0); } while (0)
#define PG8_LDA(dst, b, h) do { _Pragma("unroll") for (int m = 0; m < 4; ++m) _Pragma("unroll") for (int k = 0; k < 2; ++k) dst[m][k] = *(const PG8_LAS bf16x8*)(lds + PG8_SA(b, h) + aoff + m * 2048 + k * 1024); } while (0)
#define PG8_LDB(dst, b, h) do { _Pragma("unroll") for (int n = 0; n < 2; ++n) _Pragma("unroll") for (int k = 0; k < 2; ++k) dst[n][k] = *(const PG8_LAS bf16x8*)(lds + PG8_SB(b, h) + boff + n * 2048 + k * 1024); } while (0)
#define PG8_MMA(ai, bj, At, Bt) do { __builtin_amdgcn_s_setprio(1); _Pragma("unroll") for (int m = 0; m < 4; ++m) _Pragma("unroll") for (int n = 0; n < 2; ++n) _Pragma("unroll") for (int k = 0; k < 2; ++k) \
        acc[ai][bj][m][n] = __builtin_amdgcn_mfma_f32_16x16x32_bf16(Bt[n][k], At[m][k], acc[ai][bj][m][n], 0, 0, 0); __builtin_amdgcn_s_setprio(0); } while (0)
#define PG8_WAIT_V(n) asm volatile("s_waitcnt vmcnt(" #n ")" ::: "memory")
#define PG8_WAIT_L(n) asm volatile("s_waitcnt lgkmcnt(" #n ")" ::: "memory")
#define PG8_BAR __builtin_amdgcn_s_barrier()
#define PG8_SCHED __builtin_amdgcn_sched_barrier(0)
    Unit cur, nxt; int ui = 0;
    if (!S.next(0, cur)) return;
    f32x4 acc[2][2][4][2];
#pragma unroll
    for (int a = 0; a < 2; ++a)
#pragma unroll
        for (int b = 0; b < 2; ++b)
#pragma unroll
            for (int m = 0; m < 4; ++m)
#pragma unroll
                for (int n = 0; n < 2; ++n) acc[a][b][m][n] = (f32x4){0.f, 0.f, 0.f, 0.f};
    bf16x8 At[4][2], B0[2][2], B1[2][2];
    const char* cA = Sched::GATHER ? (const char*)g.A : (const char*)g.A + (size_t)cur.pm * tstep; const char* cB = (const char*)g.Bt + (size_t)cur.pn * tstep + S.boff(cur);
    unsigned goA[2][2]; int gR[2], gC2[2];
    PG8_LAS int* const gidx = (PG8_LAS int*)(lds + STAGE_BYTES);
    if constexpr (Sched::GATHER) {
#pragma unroll
        for (int i = 0; i < 2; ++i) { int R, C; stage_rc(tid * 16 + i * 8192, R, C); gR[i] = R; gC2[i] = 2 * C; }
#pragma unroll
        for (int h = 0; h < 2; ++h)
#pragma unroll
            for (int i = 0; i < 2; ++i) { const int t_ = *(const PG8_GAS int*)(S.rowidx() + cur.pm * BM + h * HALF + gR[i]); goA[h][i] = (unsigned)(t_ < 0 ? 0 : t_) * (unsigned)(2 * K) + (unsigned)gC2[i]; }
    }
#define PG8_GOFF(nb_, h, i) ((unsigned)(gidx[(nb_) * 256 + (h) * HALF + gR[i]] < 0 ? 0 : gidx[(nb_) * 256 + (h) * HALF + gR[i]]) * (unsigned)(2 * K) + (unsigned)gC2[i])
#define PG8_STAGE_A(bufoff, base_ng, h, kt, nextu) do { if constexpr (Sched::GATHER) { unsigned vo_[2]; \
            if (nextu) { vo_[0] = PG8_GOFF((ui + 1) & 1, h, 0); vo_[1] = PG8_GOFF((ui + 1) & 1, h, 1); } else { vo_[0] = goA[h][0]; vo_[1] = goA[h][1]; } \
            PG8_STAGE(bufoff, (const char*)g.A + (size_t)(kt) * kstep, vo_); } else { PG8_STAGE(bufoff, (base_ng) + (h) * hstep, voffA); } } while (0)
    S.a_ready(cur);
    if constexpr (SP2) {
        PG8_STAGE(PG8_SB(0, 0), cB, voffB); PG8_STAGE(PG8_SB(0, 1), cB + hstep, voffB); PG8_STAGE_A(PG8_SA(0, 0), cA, 0, 0, false); PG8_STAGE_A(PG8_SA(0, 1), cA, 1, 0, false);
        if (wr == 1) PG8_BAR;
        PG8_WAIT_V(2); PG8_BAR;
        PG8_STAGE(PG8_SB(1, 0), cB + kstep, voffB); PG8_STAGE_A(PG8_SA(1, 0), cA + kstep, 0, 1, false); PG8_STAGE(PG8_SB(1, 1), cB + hstep + kstep, voffB);
        PG8_WAIT_V(6); PG8_BAR;
    } else {
        PG8_STAGE(PG8_SB(0, 0), cB, voffB); PG8_STAGE(PG8_SA(0, 0), cA, voffA); PG8_STAGE(PG8_SB(0, 1), cB + hstep, voffB); PG8_STAGE(PG8_SA(0, 1), cA + hstep, voffA);
        if (wr == 1) PG8_BAR;
        PG8_WAIT_V(4); PG8_BAR;
        PG8_STAGE(PG8_SB(1, 0), cB + kstep, voffB); PG8_STAGE(PG8_SA(1, 0), cA + kstep, voffA); PG8_STAGE(PG8_SB(1, 1), cB + hstep + kstep, voffB);
        PG8_WAIT_V(6); PG8_BAR;
    }
    for (;;) {
        const bool has_next = S.next(ui + 1, nxt);
        const char* nA = Sched::GATHER ? cA : (has_next ? (const char*)g.A + (size_t)nxt.pm * tstep : cA); const char* nB = has_next ? (const char*)g.Bt + (size_t)nxt.pn * tstep + S.boff(nxt) : cB;
        if constexpr (Sched::GATHER) {
            const int gpm = has_next ? nxt.pm : cur.pm;
            if (wid < 4) __builtin_amdgcn_global_load_lds((const unsigned*)(S.rowidx() + gpm * BM + wid * 64 + lane), (PG8_LAS unsigned*)(gidx + ((ui + 1) & 1) * 256 + wid * 64), 4, 0, 0);
        }
        for (int t = 0; t < nt; t += 2) {
            const bool last = (t == nt - 2);
            const char* a1 = cA + (size_t)(t + 1) * kstep;
            const char* a2 = last ? nA : cA + (size_t)(t + 2) * kstep; const char* b2 = last ? nB : cB + (size_t)(t + 2) * kstep;
            const char* a3 = a2 + kstep; const char* b3 = b2 + kstep;
            if (last && has_next) S.a_ready(nxt);
            if constexpr (SP2) {
            PG8_LDB(B0, 0, 0); PG8_LDB(B1, 0, 1); PG8_SCHED; PG8_LDA(At, 0, 0); PG8_STAGE_A(PG8_SA(1, 1), a1, 1, t + 1, false);
            PG8_WAIT_V(8); PG8_WAIT_L(0); PG8_BAR; PG8_MMA(0, 0, At, B0); PG8_MMA(0, 1, At, B1); PG8_BAR; PG8_SCHED;
            PG8_LDA(At, 0, 1); PG8_STAGE(PG8_SB(0, 0), b2, voffB); PG8_STAGE(PG8_SB(0, 1), b2 + hstep, voffB); PG8_STAGE_A(PG8_SA(0, 0), a2, 0, last ? 0 : t + 2, last);
            PG8_WAIT_V(8); PG8_WAIT_L(0); PG8_BAR; PG8_MMA(1, 0, At, B0); PG8_MMA(1, 1, At, B1); PG8_BAR; PG8_SCHED;
            PG8_LDB(B0, 1, 0); PG8_LDB(B1, 1, 1); PG8_SCHED; PG8_LDA(At, 1, 0); PG8_STAGE_A(PG8_SA(0, 1), a2, 1, last ? 0 : t + 2, last);
            PG8_WAIT_V(8); PG8_WAIT_L(0); PG8_BAR; PG8_MMA(0, 0, At, B0); PG8_MMA(0, 1, At, B1); PG8_BAR; PG8_SCHED;
            PG8_LDA(At, 1, 1); PG8_STAGE(PG8_SB(1, 0), b3, voffB); PG8_STAGE(PG8_SB(1, 1), b3 + hstep, voffB); PG8_STAGE_A(PG8_SA(1, 0), a3, 0, last ? 1 : t + 3, last);
            PG8_WAIT_V(8); PG8_WAIT_L(0); PG8_BAR; PG8_MMA(1, 0, At, B0); PG8_MMA(1, 1, At, B1); PG8_BAR; PG8_SCHED;
            } else {
            PG8_LDB(B0, 0, 0); PG8_SCHED; PG8_LDA(At, 0, 0); PG8_STAGE(PG8_SA(1, 1), a1 + hstep, voffA);
            PG8_WAIT_L(8); PG8_BAR; PG8_WAIT_L(0); PG8_MMA(0, 0, At, B0); PG8_BAR; PG8_SCHED;
            PG8_LDB(B1, 0, 1); PG8_STAGE(PG8_SB(0, 0), b2, voffB);
            PG8_BAR; PG8_WAIT_L(0); PG8_MMA(0, 1, At, B1); PG8_BAR;
            PG8_LDA(At, 0, 1); PG8_STAGE(PG8_SA(0, 0), a2, voffA);
            PG8_BAR; PG8_WAIT_L(0); PG8_MMA(1, 0, At, B0); PG8_BAR; PG8_SCHED;
            PG8_STAGE(PG8_SB(0, 1), b2 + hstep, voffB);
            PG8_WAIT_V(6); PG8_BAR; PG8_MMA(1, 1, At, B1); PG8_BAR;
            PG8_LDB(B0, 1, 0); PG8_SCHED; PG8_LDA(At, 1, 0); PG8_STAGE(PG8_SA(0, 1), a2 + hstep, voffA);
            PG8_WAIT_L(8); PG8_BAR; PG8_WAIT_L(0); PG8_MMA(0, 0, At, B0); PG8_BAR; PG8_SCHED;
            PG8_LDB(B1, 1, 1); PG8_STAGE(PG8_SB(1, 0), b3, voffB);
            PG8_BAR; PG8_WAIT_L(0); PG8_MMA(0, 1, At, B1); PG8_BAR;
            PG8_LDA(At, 1, 1); PG8_STAGE(PG8_SA(1, 0), a3, voffA);
            PG8_BAR; PG8_WAIT_L(0); PG8_MMA(1, 0, At, B0); PG8_BAR; PG8_SCHED;
            PG8_STAGE(PG8_SB(1, 1), b3 + hstep, voffB);
            PG8_WAIT_V(6); PG8_BAR; PG8_MMA(1, 1, At, B1); PG8_BAR;
            }
        }
        if constexpr (ALIGN_EPI) { if (wr == 0) PG8_BAR; }
        if constexpr (!Epi::AFTER_DRAIN) { E(acc, cur, wr, wc, fr, fq); S.done(cur); }
        if (!has_next) break;
#pragma unroll
        for (int a = 0; a < 2; ++a)
#pragma unroll
            for (int b = 0; b < 2; ++b)
#pragma unroll
                for (int m = 0; m < 4; ++m)
#pragma unroll
                    for (int n = 0; n < 2; ++n) acc[a][b][m][n] = (f32x4){0.f, 0.f, 0.f, 0.f};
        if constexpr (Sched::GATHER) {
#pragma unroll
            for (int h = 0; h < 2; ++h)
#pragma unroll
                for (int i = 0; i < 2; ++i) goA[h][i] = PG8_GOFF((ui + 1) & 1, h, i); }
        cur = nxt; cA = nA; cB = nB; ++ui;
        if constexpr (ALIGN_EPI) { if (wr == 1) PG8_BAR; }
    }
    PG8_WAIT_V(0);
    if constexpr (!ALIGN_EPI) { if (wr == 0) PG8_BAR; }
    PG8_BAR;
    if constexpr (Epi::AFTER_DRAIN) { E.fused(acc, cur, wr, wc, fr, fq, lds, wid, lane); S.done(cur); }
#undef PG8_SA
#undef PG8_SB
#undef PG8_STAGE
#undef PG8_STAGE_A
#undef PG8_GOFF
#undef PG8_LDA
#undef PG8_LDB
#undef PG8_MMA
#undef PG8_WAIT_V
#undef PG8_WAIT_L
#undef PG8_BAR
#undef PG8_SCHED
}
}

constexpr int DM = 1024, NBATCH = 32, SEQ = 2048, CTXL = 256, DEPTH = 4;
constexpr int M_LAT = NBATCH * SEQ, M_CTX = NBATCH * CTXL, M_ALL = M_LAT + M_CTX;
constexpr int DIN = 3840, DFF = 2816, NEXP = 8;
constexpr int PA_Q = 0, PA_K = 256, PA_V = 512, PB_Q = 768, PB_I = 1280, PB_FF = 1792, PB_FB = 2304, PB_G = 2816, PC_Q = 3328, PC_K = 3584, PC_V = 3712;
constexpr float NORM_EPS = 1e-6f;
constexpr int NWAVES = 8, NTHREADS = 512;

constexpr size_t MiB = 1u << 20;
constexpr size_t WS_CTL = 0, CTL_ZERO_BYTES = 1 * MiB;
constexpr size_t WS_MOD = 1 * MiB;
constexpr int MOE_MAXR = 75776;
constexpr size_t WS_ROWINFO = 5 * MiB;
constexpr size_t WS_TOK = 6 * MiB + 512 * 1024;
constexpr size_t WS_WGT = 7 * MiB + 128 * 1024;
constexpr size_t WS_CNT = 7 * MiB + 896 * 1024;
constexpr size_t WS_CTXRES = 8 * MiB;
constexpr size_t WS_WINT = 40 * MiB;
constexpr size_t WS_WOUTT = 70 * MiB;
constexpr size_t WS_W13T = 78 * MiB;
constexpr size_t WS_W2T = 100 * MiB;
constexpr size_t WS_MW13T = 112 * MiB;
constexpr size_t WS_MW2T = 200 * MiB;
constexpr size_t WS_XB = 244 * MiB;
constexpr size_t WS_BIG = 388 * MiB;
constexpr size_t WS_HIDM = WS_BIG + 148 * MiB;
constexpr size_t WS_ACT2 = WS_BIG + 400 * MiB;
constexpr size_t WS_BG1 = 972 * MiB;
constexpr size_t WS_BF1 = 974 * MiB;
constexpr size_t WS_GSC = 976 * MiB;
constexpr size_t WS_SSP = 977 * MiB;
constexpr size_t WS_SBF = 982 * MiB;
constexpr size_t WS_END = 985 * MiB;
constexpr int CW_BAR = 4096;

constexpr int RING_OFF = 0, RING_BYTES = 131072;
constexpr int LDSCTL_OFF = 146944, LDS_BYTES = 147456;

#define GAS __attribute__((address_space(1)))
#define LAS __attribute__((address_space(3)))
typedef unsigned short bf16;
typedef unsigned v4u __attribute__((ext_vector_type(4)));
typedef unsigned v2u __attribute__((ext_vector_type(2)));
typedef float f32x4 __attribute__((ext_vector_type(4)));
typedef GAS unsigned gu32;
#define LDS_WAIT() asm volatile("s_waitcnt lgkmcnt(0)" ::: "memory")
__device__ __forceinline__ unsigned f2bf(float f) { unsigned u = __builtin_bit_cast(unsigned, f); return (u + 0x7fffu + ((u >> 16) & 1u)) >> 16; }
typedef float f32x2_t __attribute__((ext_vector_type(2))); typedef __bf16 bf16x2_t __attribute__((ext_vector_type(2)));
__device__ __forceinline__ unsigned pk2(float lo, float hi) { f32x2_t v = {lo, hi}; bf16x2_t b = __builtin_convertvector(v, bf16x2_t); return __builtin_bit_cast(unsigned, b); }
__device__ __forceinline__ float bflo(unsigned u) { return __builtin_bit_cast(float, u << 16); }
__device__ __forceinline__ float bfhi(unsigned u) { return __builtin_bit_cast(float, u & 0xffff0000u); }
__device__ __forceinline__ float wave_sum(float v, int lane) {
#pragma unroll
    for (int o = 1; o < 64; o <<= 1) v += __builtin_bit_cast(float, __builtin_amdgcn_ds_bpermute((lane ^ o) << 2, __builtin_bit_cast(int, v)));
    return v;
}
__device__ __forceinline__ float wave_max(float v, int lane) {
#pragma unroll
    for (int o = 1; o < 64; o <<= 1) v = fmaxf(v, __builtin_bit_cast(float, __builtin_amdgcn_ds_bpermute((lane ^ o) << 2, __builtin_bit_cast(int, v))));
    return v;
}
__device__ __forceinline__ float sigmoid_f(float x) { return __builtin_amdgcn_rcpf(1.f + __expf(-x)); }
__device__ __forceinline__ float silu1(float a) { return a * __builtin_amdgcn_rcpf(1.f + __expf(-a)); }
#define XB_TMO      128
#define XB_XCNT(j)  (256  + 64 * (j))
#define XB_XSUB(j)  (1280 + 64 * (j))
#define XB_XGEN(j)  (2304 + 64 * (j))
#define XB_TOP      3328
#define XB_TOPGEN   3392
#define XCD_BAR_WORDS 3456
#define XB_SPIN_CAP (1u << 24)

__device__ __forceinline__ unsigned xb_ld(unsigned* p)              { return __hip_atomic_load(p, __ATOMIC_RELAXED, __HIP_MEMORY_SCOPE_AGENT); }
__device__ __forceinline__ unsigned xb_add(unsigned* p, unsigned v) { return __hip_atomic_fetch_add(p, v, __ATOMIC_RELAXED, __HIP_MEMORY_SCOPE_AGENT); }
__device__ __forceinline__ unsigned xb_xcc_id() { return (unsigned)__builtin_amdgcn_s_getreg((3 << 11) | 20) & 0xFu; }
#define XB_SPIN(cond, bar) do { unsigned _sp = 0; while (cond) { __builtin_amdgcn_s_sleep(1); \
    if ((++_sp & 255u) == 0u) { if (xb_ld(&(bar)[XB_TMO])) break; if (_sp > XB_SPIN_CAP) { atomicAdd(&(bar)[XB_TMO], 1u); break; } } } } while (0)

struct XcdBarrier {
    unsigned* bar; unsigned x;
    volatile LAS unsigned* st;
};

__device__ __forceinline__ XcdBarrier xcd_barrier_post(unsigned* bar, volatile LAS unsigned* st) {
    XcdBarrier b; b.bar = bar; b.x = xb_xcc_id(); b.st = st;
    if (threadIdx.x == 0) (void)xb_add(&bar[XB_XCNT(b.x)], 1u);
    return b;
}
__device__ __forceinline__ void xcd_barrier_complete(unsigned* bar, unsigned x, unsigned& nloc, unsigned& nx) {
    const unsigned G = gridDim.x * gridDim.y * gridDim.z;
    unsigned sum, cnt, mine, sp = 0u;
    for (;;) {
        sum = 0u; cnt = 0u; mine = 0u;
#pragma unroll
        for (unsigned j = 0; j < 16; ++j) { const unsigned c = xb_ld(&bar[XB_XCNT(j)]); sum += c; cnt += (c > 0u) ? 1u : 0u; mine = (j == x) ? c : mine; }
        if (sum == G) break;
        __builtin_amdgcn_s_sleep(1);
        if ((++sp & 255u) == 0u) { if (xb_ld(&bar[XB_TMO])) break; if (sp > XB_SPIN_CAP) { atomicAdd(&bar[XB_TMO], 1u); break; } }
    }
    nloc = mine > 0u ? mine : 1u; nx = cnt > 0u ? cnt : 1u;
}

__device__ __forceinline__ void xcd_barrier(const XcdBarrier& b) {
    asm volatile("s_waitcnt vmcnt(0)" ::: "memory");
    __syncthreads();
    if (threadIdx.x == 0) {
        unsigned* bar = b.bar;
        __builtin_amdgcn_s_waitcnt(0);
        unsigned nloc = b.st[0], nx = b.st[1];
        if (nloc == 0u) { xcd_barrier_complete(bar, b.x, nloc, nx); b.st[0] = nloc; b.st[1] = nx; }
        const unsigned old = xb_add(&bar[XB_XSUB(b.x)], 1u);
        const unsigned gen = old / nloc;
        if (old + 1u == (gen + 1u) * nloc) {
            __builtin_amdgcn_fence(__ATOMIC_RELEASE, "agent");
            asm volatile("s_waitcnt vmcnt(0)" ::: "memory");
            const unsigned og = xb_add(&bar[XB_TOP], 1u);
            const unsigned tg = og / nx;
            if (og + 1u == (tg + 1u) * nx) xb_add(&bar[XB_TOPGEN], 1u);
            else XB_SPIN(xb_ld(&bar[XB_TOPGEN]) == tg, bar);
            __builtin_amdgcn_fence(__ATOMIC_ACQUIRE, "agent");
            xb_add(&bar[XB_XGEN(b.x)], 1u);
            asm volatile("s_waitcnt vmcnt(0)" ::: "memory");
        } else {
            XB_SPIN(xb_ld(&bar[XB_XGEN(b.x)]) == gen, bar);
            __builtin_amdgcn_fence(__ATOMIC_ACQUIRE, "agent");
            asm volatile("s_waitcnt vmcnt(0)" ::: "memory");
        }
    }
    __syncthreads();
}


struct Frame { LAS unsigned char* lds; volatile LAS unsigned* MISC; int tid, lane, wave, vcu, G; };
constexpr int SEGT_OFF = LDSCTL_OFF + 336, BASE_OFF = LDSCTL_OFF + 408;
constexpr int PTR_OFF = LDSCTL_OFF + 128;
__device__ __forceinline__ unsigned long long ldp64(const Frame& F, int i) {
    const volatile LAS unsigned* p = (const volatile LAS unsigned*)(F.lds + PTR_OFF) + 2 * i;
    const unsigned lo = __builtin_amdgcn_readfirstlane(p[0]), hi = __builtin_amdgcn_readfirstlane(p[1]);
    return ((unsigned long long)hi << 32) | lo;
}
#define INP(i) ((const float*)ldp64(F, (i)))
#define OUTP() ((float*)ldp64(F, 24))
#define ACTP() ((bf16*)ldp64(F, 24))
#define WSP() ((unsigned char*)ldp64(F, 25))

__device__ __forceinline__ int win_row_of_col(int c) {
    if (c < 512) { const int d = c & 31, fq = 2 * (d >> 4) + ((d >> 2) & 1), n = (d >> 3) & 1; return (c & ~31) + 8 * fq + 4 * n + (d & 3); }
    if (c >= 3328) { const int e = c - 3328, pn = 13 + (e >> 8), wc = (e >> 6) & 3, dd = e & 63; return pn * 256 + 128 * (dd >> 5) + 32 * wc + 8 * ((dd >> 2) & 3) + 4 * ((dd >> 4) & 1) + (dd & 3); }
    { const int e = c & 255; return (c & ~255) + 128 * ((e >> 5) & 1) + 32 * (e >> 6) + (e & 31); }
}
__device__ __forceinline__ void tr_item(const float* W, int N, bf16* WT, int K, int drow0, int k0, int n0, LAS float* scr, int lane, bool perm_win = false) {
    const int kr = lane >> 4, nc = (lane & 15) * 4;
    f32x4 v[16];
#pragma unroll
    for (int i = 0; i < 16; ++i) v[i] = *(const GAS f32x4*)(W + (size_t)(k0 + 4 * i + kr) * N + n0 + nc);
#pragma unroll
    for (int i = 0; i < 16; ++i) { LAS float* d = scr + (4 * i + kr) * 65 + nc; d[0] = v[i][0]; d[1] = v[i][1]; d[2] = v[i][2]; d[3] = v[i][3]; }
    LDS_WAIT(); asm volatile("" ::: "memory");
    const int c = lane & 7;
#pragma unroll
    for (int j = 0; j < 8; ++j) { const int n = (lane >> 3) + 8 * j; const LAS float* sp = scr + (8 * c) * 65 + n;
        v4u o; o.x = pk2(sp[0 * 65], sp[1 * 65]); o.y = pk2(sp[2 * 65], sp[3 * 65]); o.z = pk2(sp[4 * 65], sp[5 * 65]); o.w = pk2(sp[6 * 65], sp[7 * 65]);
        *(GAS v4u*)(WT + (size_t)(perm_win ? win_row_of_col(drow0 + n) : drow0 + n) * K + k0 + 8 * c) = o; }
    LDS_WAIT(); asm volatile("" ::: "memory");
}
__device__ __forceinline__ void tr_matrix(Frame& F, const float* W, int K, int N, bf16* WT, int mode, int& base, LAS float* scr) {
    const int gw = F.vcu * NWAVES + F.wave, NGW = F.G * NWAVES;
    const int nblk = N / 64, nitems = (K / 64) * nblk;
    int start = (gw - base) % NGW; if (start < 0) start += NGW;
    for (int it = start; it < nitems; it += NGW) { const int kb = it / nblk, nb = it % nblk, n0 = nb * 64;
        const int drow0 = (mode == 0 || mode == 3) ? n0 : ((n0 >> 7) * 256 + (mode - 1) * 128 + (n0 & 127));
        tr_item(W, N, WT, K, drow0, kb * 64, n0, scr, F.lane, mode == 3); }
    base += nitems;
}
__device__ __forceinline__ void mod_partial(Frame& F, const float* c, const float* cctx, const float* ada_w, float* PART) {
    LAS float* s = (LAS float*)F.lds;
    for (int i = F.tid; i < 33 * 1024; i += NTHREADS) { const float v = i < 32 * 1024 ? c[i] : cctx[i - 32 * 1024]; s[i] = silu1(v); }
    __syncthreads();
    const int gw = F.vcu * NWAVES + F.wave, NGW = F.G * NWAVES;
    for (int it = gw; it < 4 * 24 * 3 * 8; it += NGW) {
        const int kc = it & 7, rg = (it >> 3) % 3, cb = (it / 24) % 24, L = it / 576;
        const GAS float* wbase = (const GAS float*)ada_w + (size_t)L * 1024 * 6144 + (size_t)(kc * 128) * 6144 + cb * 256;
        f32x4 acc[11];
#pragma unroll
        for (int r = 0; r < 11; ++r) acc[r] = (f32x4){0.f, 0.f, 0.f, 0.f};
#pragma unroll 1
        for (int k = 0; k < 128; k += 16) {
            const GAS float* wk = wbase + (size_t)k * 6144;
            f32x4 wv[16];
#pragma unroll
            for (int kk = 0; kk < 16; ++kk) wv[kk] = *(const GAS f32x4*)(wk + kk * 6144 + F.lane * 4);
#pragma unroll
            for (int k4 = 0; k4 < 4; ++k4)
#pragma unroll
                for (int r = 0; r < 11; ++r) { const f32x4 sv = *(const LAS f32x4*)(s + (rg * 11 + r) * 1024 + kc * 128 + k + 4 * k4);
                    acc[r] += (wv[4 * k4] * sv[0] + wv[4 * k4 + 1] * sv[1]) + (wv[4 * k4 + 2] * sv[2] + wv[4 * k4 + 3] * sv[3]); }
        }
#pragma unroll
        for (int r = 0; r < 11; ++r) *(GAS f32x4*)(PART + (((size_t)kc * 4 + L) * 33 + rg * 11 + r) * 6144 + cb * 256 + F.lane * 4) = acc[r];
    }
    __syncthreads();
}
__device__ __forceinline__ void mod_finalize(Frame& F, const float* PART, const float* ada_b, float* MOD, bf16* SBF) {
    { const v4u z = {0u, 0u, 0u, 0u};
#pragma unroll 1
      for (int i = F.vcu * NTHREADS + F.tid; i < 5 * 223 * 128; i += F.G * NTHREADS) { const int t = i / (223 * 128), q = i % (223 * 128); *(GAS v4u*)(SBF + ((size_t)t * 256 + 33) * 1024 + (size_t)q * 8) = z; } }
#pragma unroll 1
    for (int i = F.vcu * NTHREADS + F.tid; i < 4 * 33 * 1536; i += F.G * NTHREADS) {
        const int n = (i % 1536) * 4, lr = i / 1536, L = lr / 33, r = lr % 33;
        f32x4 v = *(const GAS f32x4*)(ada_b + L * 6144 + n);
#pragma unroll
        for (int kc = 0; kc < 8; ++kc) v += *(const GAS f32x4*)(PART + (((size_t)kc * 4 + L) * 33 + r) * 6144 + n);
        *(GAS f32x4*)(MOD + ((size_t)L * 33 + r) * 6144 + n) = v;
        const int chunk = n >> 10, sbt = (chunk == 0 && L >= 1) ? L - 1 : ((chunk == 3 && !(L & 1)) ? 3 + (L >> 1) : -1);
        if (sbt >= 0) { v2u o; o.x = pk2(v[0], v[1]); o.y = pk2(v[2], v[3]); *(GAS v2u*)(SBF + ((size_t)sbt * 256 + r) * 1024 + (n & 1023)) = o; }
    }
}

template <bool ROUTE, bool XF32>
__device__ __forceinline__ void norm_phase(Frame& F, const void* xl_, const void* xc_, bf16* xb, int nrows, const float* gain, const float* modL, int sh, int sc, bf16* out, const float* router, int* rowinfo, int* cntg, int* tok) {
    LAS float* rt = (LAS float*)F.lds;
    LAS int* cnt = (LAS int*)(F.lds + 32768);
    float rw[8][16];
    if (ROUTE) {
#pragma unroll
        for (int j = 0; j < 4; ++j)
#pragma unroll
            for (int i = 0; i < 4; ++i) { const GAS f32x4* rp = (const GAS f32x4*)(router + (size_t)(4 * F.lane + 256 * j + i) * 8); const f32x4 a = rp[0], b = rp[1];
                rw[0][4 * j + i] = a[0]; rw[1][4 * j + i] = a[1]; rw[2][4 * j + i] = a[2]; rw[3][4 * j + i] = a[3]; rw[4][4 * j + i] = b[0]; rw[5][4 * j + i] = b[1]; rw[6][4 * j + i] = b[2]; rw[7][4 * j + i] = b[3]; }
        if (F.tid < 16) cnt[F.tid] = 0;
        { int i = F.vcu * NTHREADS + F.tid; while (i < 2 * MOE_MAXR) { tok[i] = -1; i += F.G * NTHREADS; asm volatile("" : "+v"(i)); } }
        __syncthreads(); }
    const int gw = F.vcu * NWAVES + F.wave, NGW = F.G * NWAVES, lane = F.lane;
    f32x4 gv[4];
#pragma unroll
    for (int j = 0; j < 4; ++j) gv[j] = *(const GAS f32x4*)(gain + 4 * lane + 256 * j);
    const float* xl = (const float*)xl_; const float* xc = (const float*)xc_; const bf16* xlb = (const bf16*)xl_; const bf16* xcb = (const bf16*)xc_;
    f32x4 vn[4]; v2u un[4];
#define NP_LOAD(rr) do { if (XF32) { const float* src_ = (rr) < M_LAT ? xl + (size_t)(rr) * DM : xc + (size_t)((rr) - M_LAT) * DM; \
            _Pragma("unroll") for (int j_ = 0; j_ < 4; ++j_) vn[j_] = *(const GAS f32x4*)(src_ + 4 * lane + 256 * j_); } \
        else { const bf16* src_ = (rr) < M_LAT ? xlb + (size_t)(rr) * DM : xcb + (size_t)((rr) - M_LAT) * DM; \
            _Pragma("unroll") for (int j_ = 0; j_ < 4; ++j_) un[j_] = *(const GAS v2u*)(src_ + 4 * lane + 256 * j_); } } while (0)
    if (gw < nrows) NP_LOAD(gw);
    for (int r = gw; r < nrows; r += NGW) {
        const bool lat = r < M_LAT;
        const float* md = modL + (size_t)(lat ? (r >> 11) : 32) * 6144;
        f32x4 v[4]; float ss = 0.f;
#pragma unroll
        for (int j = 0; j < 4; ++j) { if (XF32) v[j] = vn[j]; else { v[j][0] = bflo(un[j].x); v[j][1] = bfhi(un[j].x); v[j][2] = bflo(un[j].y); v[j][3] = bfhi(un[j].y); } }
        if (XF32 && xb) {
#pragma unroll
            for (int j = 0; j < 4; ++j) { v2u o; o.x = pk2(v[j][0], v[j][1]); o.y = pk2(v[j][2], v[j][3]); *(GAS v2u*)(xb + (size_t)r * DM + 4 * lane + 256 * j) = o; } }
        f32x4 scq[4], shq[4];
#pragma unroll
        for (int j = 0; j < 4; ++j) { scq[j] = *(const GAS f32x4*)(md + sc * 1024 + 4 * lane + 256 * j); shq[j] = *(const GAS f32x4*)(md + sh * 1024 + 4 * lane + 256 * j); }
        { const int rn = r + NGW; if (rn < nrows) NP_LOAD(rn); }
#pragma unroll
        for (int j = 0; j < 4; ++j) ss += (v[j][0] * v[j][0] + v[j][1] * v[j][1]) + (v[j][2] * v[j][2] + v[j][3] * v[j][3]);
        ss = wave_sum(ss, lane);
        const float rstd = rsqrtf(ss * (1.f / DM) + NORM_EPS);
#pragma unroll
        for (int j = 0; j < 4; ++j) { const f32x4 scv = scq[j], shv = shq[j];
            v[j] = (v[j] * rstd * gv[j]) * (scv + 1.f) + shv;
            v2u o; o.x = pk2(v[j][0], v[j][1]); o.y = pk2(v[j][2], v[j][3]);
            *(GAS v2u*)(out + (size_t)r * DM + 4 * lane + 256 * j) = o; }
        if (ROUTE) {
            float pp[8];
#pragma unroll
            for (int e = 0; e < 8; ++e) { float p = 0.f;
#pragma unroll
                for (int j = 0; j < 4; ++j) p += (v[j][0] * rw[e][4 * j] + v[j][1] * rw[e][4 * j + 1]) + (v[j][2] * rw[e][4 * j + 2] + v[j][3] * rw[e][4 * j + 3]);
                pp[e] = p; }
            float q4[4], q2[2], q1;
            { const bool up = (lane & 4) != 0;
#pragma unroll
              for (int e = 0; e < 4; ++e) { const float keep = up ? pp[4 + e] : pp[e], give = up ? pp[e] : pp[4 + e]; q4[e] = keep + __builtin_bit_cast(float, __builtin_amdgcn_ds_bpermute((lane ^ 4) << 2, __builtin_bit_cast(int, give))); } }
            { const bool up = (lane & 2) != 0;
#pragma unroll
              for (int e = 0; e < 2; ++e) { const float keep = up ? q4[2 + e] : q4[e], give = up ? q4[e] : q4[2 + e]; q2[e] = keep + __builtin_bit_cast(float, __builtin_amdgcn_ds_bpermute((lane ^ 2) << 2, __builtin_bit_cast(int, give))); } }
            { const bool up = (lane & 1) != 0; const float keep = up ? q2[1] : q2[0], give = up ? q2[0] : q2[1]; q1 = keep + __builtin_bit_cast(float, __builtin_amdgcn_ds_bpermute((lane ^ 1) << 2, __builtin_bit_cast(int, give))); }
#pragma unroll
            for (int o = 8; o < 64; o <<= 1) q1 += __builtin_bit_cast(float, __builtin_amdgcn_ds_bpermute((lane ^ o) << 2, __builtin_bit_cast(int, q1)));
            float lg[8];
#pragma unroll
            for (int e = 0; e < 8; ++e) lg[e] = __builtin_bit_cast(float, __builtin_amdgcn_ds_bpermute(e << 2, __builtin_bit_cast(int, q1)));
            int i1 = 0; float v1 = lg[0];
#pragma unroll
            for (int e = 1; e < 8; ++e) if (lg[e] > v1) { v1 = lg[e]; i1 = e; }
            int i2 = -1; float v2 = -3.0e38f;
#pragma unroll
            for (int e = 0; e < 8; ++e) if (e != i1 && lg[e] > v2) { v2 = lg[e]; i2 = e; }
            const float wa = 1.f / (1.f + expf(v2 - v1)), wb = 1.f - wa;
            if (lane == 0) { const int l1 = __hip_atomic_fetch_add(cnt + i1, 1, __ATOMIC_RELAXED, __HIP_MEMORY_SCOPE_WORKGROUP), l2 = __hip_atomic_fetch_add(cnt + 8 + i2, 1, __ATOMIC_RELAXED, __HIP_MEMORY_SCOPE_WORKGROUP);
                v4u ri; ri.x = (unsigned)(i1 | (l1 << 4)); ri.y = __builtin_bit_cast(unsigned, wa); ri.z = (unsigned)(i2 | (l2 << 4)); ri.w = __builtin_bit_cast(unsigned, wb);
                *(GAS v4u*)(rowinfo + (size_t)r * 4) = ri; }
        }
    }
#undef NP_LOAD
    if (ROUTE) { __syncthreads(); if (F.tid < 16) cntg[F.vcu * 16 + F.tid] = cnt[F.tid]; }
}
__device__ __forceinline__ void moe_setup(Frame& F, const int* cntg) {
    LAS int* tmp = (LAS int*)F.lds; volatile LAS int* SEGT = (volatile LAS int*)(F.lds + SEGT_OFF); volatile LAS int* BASE = (volatile LAS int*)(F.lds + BASE_OFF);
    __syncthreads();
    for (int i = F.tid; i < F.G * 16; i += NTHREADS) tmp[i] = cntg[i];
    __syncthreads();
    if (F.tid < 16) { int tot = 0, bef = 0; for (int w = 0; w < F.G; ++w) { const int c = tmp[w * 16 + F.tid]; tot += c; bef += w < F.vcu ? c : 0; } tmp[4096 + F.tid] = tot; tmp[4112 + F.tid] = bef; }
    __syncthreads();
    if (F.tid < 2) { int off = 0; for (int e = 0; e < 8; ++e) { SEGT[F.tid * 9 + e] = off >> 8; off += (tmp[4096 + F.tid * 8 + e] + 255) & ~255; } SEGT[F.tid * 9 + 8] = off >> 8; }
    __syncthreads();
    if (F.tid < 16) BASE[F.tid] = SEGT[(F.tid >> 3) * 9 + (F.tid & 7)] * 256 + tmp[4112 + F.tid];
    __syncthreads();
}
__device__ __forceinline__ void moe_gather(Frame& F, int s, int nrows, const bf16* act, bf16* h2s, const int* rowinfo, int* tok, float* wgt) {
    const int NGW = F.G * NWAVES; volatile LAS int* BASE = (volatile LAS int*)(F.lds + BASE_OFF);
    int tz = threadIdx.x; asm volatile("" : "+v"(tz));
    const int r = (tz >> 3) * NGW + F.vcu * NWAVES + (tz & 7);
    if (r < nrows) {
        const int c0 = rowinfo[(size_t)r * 4 + 2 * s], c1 = rowinfo[(size_t)r * 4 + 2 * s + 1];
        const unsigned code = (unsigned)c0; const int e = code & 15, dest = BASE[s * 8 + e] + (int)(code >> 4);
        tok[s * MOE_MAXR + dest] = r; wgt[s * MOE_MAXR + dest] = __builtin_bit_cast(float, c1); }
}

__device__ __forceinline__ void unpack8(const v4u u, float* x) { x[0] = bflo(u.x); x[1] = bfhi(u.x); x[2] = bflo(u.y); x[3] = bfhi(u.y); x[4] = bflo(u.z); x[5] = bfhi(u.z); x[6] = bflo(u.w); x[7] = bfhi(u.w); }
__device__ __forceinline__ v4u pack8(const float* x) { v4u o; o.x = pk2(x[0], x[1]); o.y = pk2(x[2], x[3]); o.z = pk2(x[4], x[5]); o.w = pk2(x[6], x[7]); return o; }

typedef float f32x16 __attribute__((ext_vector_type(16)));
typedef short s16x8 __attribute__((ext_vector_type(8)));
__device__ __forceinline__ unsigned cvtpk_s(float lo, float hi) { return pk2(lo, hi); }
#define MFMA32(a, b, c) __builtin_amdgcn_mfma_f32_32x32x16_bf16((a), (b), (c), 0, 0, 0)
typedef short v4i16_t __attribute__((ext_vector_type(4)));
__device__ __forceinline__ v2u ds_tr16(const LAS unsigned char* p) { return __builtin_bit_cast(v2u, __builtin_amdgcn_ds_read_tr16_b64_v4i16((LAS v4i16_t*)p)); }
#define VT_ADDR(vbase, key0, c0) ((vbase) + ((key0) + ((lane & 15) >> 2)) * 192 + ((c0) + 16 * ((lane >> 4) & 1) + 4 * (lane & 3)) * 2)
__device__ __forceinline__ float add1(float a, float b) { float d; asm("v_add_f32_e32 %0, %1, %2" : "=v"(d) : "v"(a), "v"(b)); return d; }
__device__ __forceinline__ float sum16(const f32x16& S) {
    const float a0 = add1(S[0], S[1]), a1 = add1(S[2], S[3]), a2 = add1(S[4], S[5]), a3 = add1(S[6], S[7]), a4 = add1(S[8], S[9]), a5 = add1(S[10], S[11]), a6 = add1(S[12], S[13]), a7 = add1(S[14], S[15]);
    return add1(add1(add1(a0, a1), add1(a2, a3)), add1(add1(a4, a5), add1(a6, a7))); }
__device__ __forceinline__ float xor32_add(float v, int lane) { return v + __builtin_bit_cast(float, __builtin_amdgcn_ds_bpermute((lane ^ 32) << 2, __builtin_bit_cast(int, v))); }
__device__ __forceinline__ void hgrn_item(Frame& F, bf16* proj, int b, int h, int dir, const float* lbl, int L, bool do_store = true) {
    LAS unsigned char* const OPS = F.lds;
    LAS unsigned char* const RAW = F.lds + 76800;
    LAS float* const TOT = (LAS float*)(F.lds + 101376); LAS float* const LBS = (LAS float*)(F.lds + 105472); LAS float* const OR = (LAS float*)(F.lds + 105984);
    LAS unsigned char* const PB = F.lds + 138752;
    __syncthreads();
    if (F.tid < 128) { const int ch = h * 128 + F.tid; float e[4], mx = -3.0e38f, sum = 0.f, lb = 0.f;
#pragma unroll
        for (int l = 0; l < 4; ++l) { e[l] = lbl[((size_t)dir * 4 + l) * 512 + ch]; mx = fmaxf(mx, e[l]); }
#pragma unroll
        for (int l = 0; l < 4; ++l) { e[l] = expf(e[l] - mx); sum += e[l]; }
#pragma unroll
        for (int l = 1; l < 4; ++l) if (l <= L) lb += e[l] / sum;
        LBS[F.tid] = lb; }
    const int lane = F.lane, r = lane & 31, hh = lane >> 5, vt = F.wave & 3, p = F.wave >> 2;
    const int kp = F.tid & 63, tq = F.tid >> 6;
    const int fcol = (dir ? PB_FB : PB_FF) + h * 128, rstep = dir ? -1 : 1;
#define HG_ROW0(c) ((c) < 8 ? M_LAT + b * 256 + (dir ? 255 - 32 * (c) : 32 * (c)) : b * 2048 + (dir ? 2047 - (32 * (c) - 256) : 32 * (c) - 256))
#define HG_DMA(c) do { const int trow_ = HG_ROW0(c) + rstep * (4 * F.wave + (lane >> 4)); const bf16* pr_ = proj + (size_t)trow_ * DIN + h * 128 + (lane & 15) * 8; \
        LAS unsigned char* dst_ = RAW + F.wave * 1024; \
        __builtin_amdgcn_global_load_lds((const unsigned*)(pr_ + PB_Q), (LAS unsigned*)(dst_), 16, 0, 0); \
        __builtin_amdgcn_global_load_lds((const unsigned*)(pr_ + PB_I), (LAS unsigned*)(dst_ + 8192), 16, 0, 0); \
        __builtin_amdgcn_global_load_lds((const unsigned*)(proj + (size_t)trow_ * DIN + fcol + (lane & 15) * 8), (LAS unsigned*)(dst_ + 16384), 16, 0, 0); } while (0)
#define HG_BAR() do { asm volatile("s_waitcnt lgkmcnt(0)" ::: "memory"); __builtin_amdgcn_s_barrier(); asm volatile("" ::: "memory"); } while (0)
#define HG_STAGE_A() do { const LAS unsigned char* rq = RAW + (4 * tq) * 256 + kp * 4; unsigned uq[4], uf[4]; \
        _Pragma("unroll") for (int j = 0; j < 4; ++j) { uq[j] = *(const LAS unsigned*)(rq + j * 256); iw[j] = *(const LAS unsigned*)(rq + 8192 + j * 256); uf[j] = *(const LAS unsigned*)(rq + 16384 + j * 256); } \
        float run0 = 1.f, run1 = 1.f; \
        _Pragma("unroll") for (int j = 0; j < 4; ++j) { const float ka = (1.f - lb0) * __builtin_amdgcn_rcpf(1.f + __expf(bflo(uf[j]))), kb = (1.f - lb1) * __builtin_amdgcn_rcpf(1.f + __expf(bfhi(uf[j]))); \
            run0 *= fmaxf(1.f - ka, 9.36e-14f); run1 *= fmaxf(1.f - kb, 9.36e-14f);     c0[j] = run0; c1[j] = run1; k0v[j] = ka; k1v[j] = kb; q0[j] = bflo(uq[j]); q1[j] = bfhi(uq[j]); }     \
        *(LAS f32x2_t*)(TOT + tq * 128 + 2 * kp) = (f32x2_t){run0, run1}; } while (0)
#define HG_STAGE_B(ob) do { LAS unsigned char* const QAw = (ob); LAS unsigned char* const KHw = (ob) + 8704; LAS unsigned char* const KCTw = (ob) + 17408; LAS unsigned char* const ITw = (ob) + 27648; LAS float* const Dvw = (LAS float*)((ob) + 37888); \
        float off0 = 1.f, off1 = 1.f, cl0 = 1.f, cl1 = 1.f; \
        _Pragma("unroll") for (int g = 0; g < 8; ++g) { const f32x2_t tv = *(const LAS f32x2_t*)(TOT + g * 128 + 2 * kp); cl0 *= tv[0]; cl1 *= tv[1]; if (g < tq) { off0 *= tv[0]; off1 *= tv[1]; } } \
        float kc0[4], kc1[4]; \
        _Pragma("unroll") for (int j = 0; j < 4; ++j) { const int t = 4 * tq + j; const float cu0 = c0[j] * off0, cu1 = c1[j] * off1;     \
            const float r0 = fminf(__builtin_amdgcn_rcpf(cu0), 5.5e34f), r1 = fminf(__builtin_amdgcn_rcpf(cu1), 5.5e34f);     \
            *(LAS unsigned*)(QAw + t * 272 + kp * 4) = pk2(q0[j] * cu0, q1[j] * cu1); \
            *(LAS unsigned*)(KHw + t * 272 + kp * 4) = pk2(k0v[j] * r0, k1v[j] * r1); \
            kc0[j] = k0v[j] * (cl0 * r0); kc1[j] = k1v[j] * (cl1 * r1); } \
        { v2u w0; w0.x = pk2(kc0[0], kc0[1]); w0.y = pk2(kc0[2], kc0[3]); *(LAS v2u*)(KCTw + (2 * kp) * 80 + tq * 8) = w0; \
          v2u w1; w1.x = pk2(kc1[0], kc1[1]); w1.y = pk2(kc1[2], kc1[3]); *(LAS v2u*)(KCTw + (2 * kp + 1) * 80 + tq * 8) = w1; } \
        { v2u w0; w0.x = (iw[0] & 0xffffu) | (iw[1] << 16); w0.y = (iw[2] & 0xffffu) | (iw[3] << 16); *(LAS v2u*)(ITw + (2 * kp) * 80 + tq * 8) = w0; \
          v2u w1; w1.x = (iw[0] >> 16) | (iw[1] & 0xffff0000u); w1.y = (iw[2] >> 16) | (iw[3] & 0xffff0000u); *(LAS v2u*)(ITw + (2 * kp + 1) * 80 + tq * 8) = w1; } \
        if (tq == 0) *(LAS f32x2_t*)(Dvw + 2 * kp) = (f32x2_t){cl0, cl1}; } while (0)
    f32x16 S[2], Oprev;
#pragma unroll
    for (int i = 0; i < 16; ++i) { S[0][i] = 0.f; S[1][i] = 0.f; Oprev[i] = 0.f; }
    float c0[4], c1[4], q0[4], q1[4], k0v[4], k1v[4]; unsigned iw[4];
    if (F.tid < 16 * 4) { unsigned z_ = 0u; asm volatile("" : "+v"(z_)); *(LAS v2u*)(PB + (F.tid >> 2) * 80 + 32 + (F.tid & 3) * 8) = (v2u){z_, z_}; }
    HG_DMA(0);
    asm volatile("s_waitcnt vmcnt(0)" ::: "memory");
    __syncthreads();
    const float lb0 = LBS[2 * kp], lb1 = LBS[2 * kp + 1];
    HG_STAGE_A();
    HG_BAR();
    HG_DMA(1);
    HG_STAGE_B(OPS);
    asm volatile("s_waitcnt vmcnt(0)" ::: "memory");
    __syncthreads();
#pragma unroll 1
    for (int blk = 0; blk < 72; ++blk) {
        LAS unsigned char* const ob = OPS + (blk & 1) * 38400;
        LAS unsigned char* const QA = ob; LAS unsigned char* const KH = ob + 8704; LAS unsigned char* const KCT = ob + 17408; LAS unsigned char* const IT = ob + 27648; LAS float* const Dv = (LAS float*)(ob + 37888);
        const bool more = blk + 1 < 72;
        if (more) HG_STAGE_A();
        if (blk > 0 && do_store) { const LAS float* orp = OR + ((blk - 1) & 1) * 4096 + vt * 1024 + r; bf16* obp = proj + (size_t)HG_ROW0(blk - 1) * DIN + fcol + vt * 32 + r;
#pragma unroll
            for (int i8 = 0; i8 < 8; ++i8) { const int i = 8 * p + i8, t = (i & 3) + 8 * (i >> 2) + 4 * hh; const float o = (p == 0 ? Oprev[i8] : Oprev[8 + i8]) + orp[t * 32];
                ((GAS bf16*)obp)[(ptrdiff_t)(rstep * t) * DIN] = (bf16)f2bf(o); } }
        f32x16 O;
#pragma unroll
        for (int i = 0; i < 16; ++i) O[i] = 0.f;
        if (F.wave < 3) {
            const int si = F.wave >> 1, ti = (F.wave + 1) >> 1, lr = lane & 15, g = lane >> 4;
            f32x4 pt = {0.f, 0.f, 0.f, 0.f};
#pragma unroll
            for (int st = 0; st < 4; ++st) { const s16x8 ka = *(const LAS s16x8*)(KH + (16 * si + lr) * 272 + (32 * st + 8 * g) * 2), qb = *(const LAS s16x8*)(QA + (16 * ti + lr) * 272 + (32 * st + 8 * g) * 2);
                pt = __builtin_amdgcn_mfma_f32_16x16x32_bf16(ka, qb, pt, 0, 0, 0); }
            if (si == ti) {
#pragma unroll
                for (int e = 0; e < 4; ++e) pt[e] = (4 * g + e) <= lr ? pt[e] : 0.f; }
            v2u pw; pw.x = pk2(pt[0], pt[1]); pw.y = pk2(pt[2], pt[3]);
            *(LAS v2u*)(PB + (16 * ti + lr) * 80 + (16 * si + 4 * g) * 2) = pw; }
        HG_BAR();
        if (blk + 2 < 72) HG_DMA(blk + 2);
        if (more) HG_STAGE_B(OPS + ((blk + 1) & 1) * 38400);
        { const s16x8 pa = *(const LAS s16x8*)(PB + r * 80 + (16 * p + 8 * hh) * 2), bi = *(const LAS s16x8*)(IT + (vt * 32 + r) * 80 + (16 * p + 8 * hh) * 2);
          O = MFMA32(pa, bi, O); }
#pragma unroll
        for (int kti = 0; kti < 2; ++kti)
#pragma unroll
            for (int s2 = 0; s2 < 2; ++s2) { v4u sw; sw.x = cvtpk_s(S[kti][8 * s2 + 0], S[kti][8 * s2 + 1]); sw.y = cvtpk_s(S[kti][8 * s2 + 2], S[kti][8 * s2 + 3]); sw.z = cvtpk_s(S[kti][8 * s2 + 4], S[kti][8 * s2 + 5]); sw.w = cvtpk_s(S[kti][8 * s2 + 6], S[kti][8 * s2 + 7]);
                const LAS unsigned char* qp = QA + r * 272 + ((2 * p + kti) * 32 + 16 * s2 + 4 * hh) * 2; const v2u lo = *(const LAS v2u*)qp, hi = *(const LAS v2u*)(qp + 16);
                v4u aw; aw.x = lo.x; aw.y = lo.y; aw.z = hi.x; aw.w = hi.y;
                O = MFMA32(__builtin_bit_cast(s16x8, aw), __builtin_bit_cast(s16x8, sw), O); }
#pragma unroll
        for (int kti = 0; kti < 2; ++kti) {
            const int k0 = (2 * p + kti) * 32;
#pragma unroll
            for (int g4 = 0; g4 < 4; ++g4) { const f32x4 dv = *(const LAS f32x4*)(Dv + k0 + 8 * g4 + 4 * hh);
                S[kti][4 * g4] *= dv[0]; S[kti][4 * g4 + 1] *= dv[1]; S[kti][4 * g4 + 2] *= dv[2]; S[kti][4 * g4 + 3] *= dv[3]; }
#pragma unroll
            for (int s2 = 0; s2 < 2; ++s2) { const s16x8 a = *(const LAS s16x8*)(KCT + (k0 + r) * 80 + s2 * 32 + hh * 16), bi = *(const LAS s16x8*)(IT + (vt * 32 + r) * 80 + s2 * 32 + hh * 16); S[kti] = MFMA32(a, bi, S[kti]); }
        }
        { LAS float* orp = OR + (blk & 1) * 4096 + vt * 1024 + r;
#pragma unroll
          for (int i8 = 0; i8 < 8; ++i8) { const int i = 8 * (1 - p) + i8; orp[((i & 3) + 8 * (i >> 2) + 4 * hh) * 32] = (p == 0 ? O[8 + i8] : O[i8]); }
          Oprev = O; }
        asm volatile("s_waitcnt vmcnt(0)" ::: "memory");
        __syncthreads();
    }
    if (do_store) { const LAS float* orp = OR + (71 & 1) * 4096 + vt * 1024 + r; bf16* obp = proj + (size_t)HG_ROW0(71) * DIN + fcol + vt * 32 + r;
#pragma unroll
        for (int i8 = 0; i8 < 8; ++i8) { const int i = 8 * p + i8, t = (i & 3) + 8 * (i >> 2) + 4 * hh; const float o = (p == 0 ? Oprev[i8] : Oprev[8 + i8]) + orp[t * 32];
            ((GAS bf16*)obp)[(ptrdiff_t)(rstep * t) * DIN] = (bf16)f2bf(o); } }
#undef HG_ROW0
#undef HG_DMA
#undef HG_BAR
#undef HG_STAGE_A
#undef HG_STAGE_B
    __syncthreads();
}
__device__ __forceinline__ void hgrn_post_phase(Frame& F, const bf16* proj, bf16* mix, const float* ng, int nrows) {
    const int gw = F.vcu * NWAVES + F.wave, NGW = F.G * NWAVES, lane = F.lane, h = lane >> 4, c0 = (lane & 15) * 8;
    float gn[8];
#pragma unroll
    for (int e = 0; e < 8; ++e) gn[e] = ng[c0 + e];
    v4u nf, nb, ng_;
    if (gw < nrows) { const bf16* pr = proj + (size_t)gw * DIN + h * 128 + c0; nf = *(const GAS v4u*)(pr + PB_FF); nb = *(const GAS v4u*)(pr + PB_FB); ng_ = *(const GAS v4u*)(pr + PB_G); }
    for (int r = gw; r < nrows; r += NGW) {
        float of[8], ob[8], gg[8]; unpack8(nf, of); unpack8(nb, ob); unpack8(ng_, gg);
        { const int rn = r + NGW; if (rn < nrows) { const bf16* pr = proj + (size_t)rn * DIN + h * 128 + c0; nf = *(const GAS v4u*)(pr + PB_FF); nb = *(const GAS v4u*)(pr + PB_FB); ng_ = *(const GAS v4u*)(pr + PB_G); } }
        float ss = 0.f;
#pragma unroll
        for (int e = 0; e < 8; ++e) { of[e] += ob[e]; ss += of[e] * of[e]; }
#pragma unroll
        for (int o = 1; o < 16; o <<= 1) ss += __builtin_bit_cast(float, __builtin_amdgcn_ds_bpermute((lane ^ o) << 2, __builtin_bit_cast(int, ss)));
        const float rs = rsqrtf(ss * (1.f / 128.f) + NORM_EPS);
#pragma unroll
        for (int e = 0; e < 8; ++e) of[e] = of[e] * rs * gn[e] * silu1(gg[e]);
        *(GAS v4u*)(mix + (size_t)r * DM + 256 + h * 128 + c0) = pack8(of); }
}
__device__ __forceinline__ void da_item(Frame& F, const bf16* proj, bf16* mix, int b, int h, int q0, bool ctxq, float lam, float lam_init, float boundl2, const float* subg) {
    LAS unsigned char* Kb = F.lds; LAS unsigned char* Vb = F.lds + 18432;
    const int lane = F.lane, r = lane & 31, hh = lane >> 5;
    const int qrow = (ctxq ? M_LAT + b * 256 : b * 2048) + q0 + 32 * F.wave + r;
    s16x8 qf[2][2];
#pragma unroll
    for (int m = 0; m < 2; ++m)
#pragma unroll
        for (int st = 0; st < 2; ++st) qf[m][st] = *(const GAS s16x8*)(proj + (size_t)qrow * DIN + PA_Q + h * 64 + m * 32 + st * 16 + hh * 8);
    f32x16 O[2][2]; float ls[2] = {0.f, 0.f};
#pragma unroll
    for (int m = 0; m < 2; ++m)
#pragma unroll
        for (int dt = 0; dt < 2; ++dt)
#pragma unroll
            for (int i = 0; i < 16; ++i) O[m][dt][i] = 0.f;
    const int ntiles = ctxq ? 4 : 36, skey = F.tid >> 3, sch = F.tid & 7;
    v4u kreg, vreg;
    { const int j = skey; const bf16* pr = proj + (size_t)(j < 256 ? M_LAT + b * 256 + j : b * 2048 + (j - 256)) * DIN; kreg = *(const GAS v4u*)(pr + PA_K + h * 64 + sch * 8); vreg = *(const GAS v4u*)(pr + PA_V + h * 64 + sch * 8); }
    __syncthreads();
#define DA_WRITE_TILE(bufi) do { *(LAS v4u*)(Kb + (bufi) * 9216 + skey * 144 + sch * 16) = kreg; \
        *(LAS v4u*)(Vb + (bufi) * 12288 + skey * 192 + sch * 16) = vreg; } while (0)
    DA_WRITE_TILE(0);
    __syncthreads();
#pragma unroll 1
    for (int kt = 0; kt < ntiles; ++kt) {
        const int cur = kt & 1;
        if (kt + 1 < ntiles) { const int j = (kt + 1) * 64 + skey; const bf16* pr = proj + (size_t)(j < 256 ? M_LAT + b * 256 + j : b * 2048 + (j - 256)) * DIN; kreg = *(const GAS v4u*)(pr + PA_K + h * 64 + sch * 8); vreg = *(const GAS v4u*)(pr + PA_V + h * 64 + sch * 8); }
#pragma unroll
        for (int blk = 0; blk < 2; ++blk) {
            s16x8 vf[2][2];
#pragma unroll
            for (int s2 = 0; s2 < 2; ++s2)
#pragma unroll
                for (int dt = 0; dt < 2; ++dt) { const LAS unsigned char* vb_ = Vb + cur * 12288;
                    const v2u lo = ds_tr16(VT_ADDR(vb_, blk * 32 + 16 * s2 + 4 * hh, dt * 32)), hi = ds_tr16(VT_ADDR(vb_, blk * 32 + 16 * s2 + 8 + 4 * hh, dt * 32));
                    v4u vw; vw.x = lo.x; vw.y = lo.y; vw.z = hi.x; vw.w = hi.y; vf[s2][dt] = __builtin_bit_cast(s16x8, vw); }
#pragma unroll
            for (int m = 0; m < 2; ++m) {
                f32x16 S;
#pragma unroll
                for (int i = 0; i < 16; ++i) S[i] = -boundl2;
#pragma unroll
                for (int st = 0; st < 2; ++st) { const s16x8 kf = *(const LAS s16x8*)(Kb + cur * 9216 + (blk * 32 + r) * 144 + m * 64 + st * 32 + hh * 16); S = MFMA32(kf, qf[m][st], S); }
#pragma unroll
                for (int i = 0; i < 16; ++i) S[i] = __builtin_amdgcn_exp2f(S[i]);
                ls[m] = add1(ls[m], sum16(S));
#pragma unroll
                for (int s2 = 0; s2 < 2; ++s2) {
                    v4u pw; pw.x = cvtpk_s(S[8 * s2 + 0], S[8 * s2 + 1]); pw.y = cvtpk_s(S[8 * s2 + 2], S[8 * s2 + 3]); pw.z = cvtpk_s(S[8 * s2 + 4], S[8 * s2 + 5]); pw.w = cvtpk_s(S[8 * s2 + 6], S[8 * s2 + 7]);
                    const s16x8 pb = __builtin_bit_cast(s16x8, pw);
#pragma unroll
                    for (int dt = 0; dt < 2; ++dt) O[m][dt] = MFMA32(vf[s2][dt], pb, O[m][dt]);
                }
            }
        }
        if (kt + 1 < ntiles) DA_WRITE_TILE(cur ^ 1);
        __syncthreads();
    }
#undef DA_WRITE_TILE
    const float inv0 = 1.f / xor32_add(ls[0], lane), inv1 = lam / xor32_add(ls[1], lane);
    float ss = 0.f;
#pragma unroll
    for (int dt = 0; dt < 2; ++dt)
#pragma unroll
        for (int i = 0; i < 16; ++i) { const float o = O[0][dt][i] * inv0 - O[1][dt][i] * inv1; O[0][dt][i] = o; ss += o * o; }
    ss = xor32_add(ss, lane);
    const float rs = rsqrtf(ss * (1.f / 64.f) + NORM_EPS) * (1.f - lam_init);
    f32x4 sgv[2][4];
#pragma unroll
    for (int dt = 0; dt < 2; ++dt)
#pragma unroll
        for (int g4 = 0; g4 < 4; ++g4) sgv[dt][g4] = *(const GAS f32x4*)(subg + dt * 32 + 8 * g4 + 4 * hh);
#pragma unroll
    for (int dt = 0; dt < 2; ++dt)
#pragma unroll
        for (int g4 = 0; g4 < 4; ++g4) { const int dv0 = dt * 32 + 8 * g4 + 4 * hh; const f32x4 sg = sgv[dt][g4];
            v2u o; o.x = pk2(O[0][dt][4 * g4] * rs * sg[0], O[0][dt][4 * g4 + 1] * rs * sg[1]); o.y = pk2(O[0][dt][4 * g4 + 2] * rs * sg[2], O[0][dt][4 * g4 + 3] * rs * sg[3]);
            *(GAS v2u*)(mix + (size_t)qrow * DM + h * 64 + dv0) = o; }
}
__device__ __forceinline__ void sw_item(Frame& F, const bf16* proj, bf16* mix, int b, int kv, int q0, bool ctxq, const float* sink4, float boundl2) {
    LAS unsigned char* Kb = F.lds; LAS unsigned char* Vb = F.lds + 18432;
    const int lane = F.lane, r = lane & 31, hh = lane >> 5, g = F.wave & 1, qb = F.wave >> 1;
    const int qp0 = q0 + 32 * qb, qrow = (ctxq ? M_LAT + b * 256 : b * 2048) + qp0 + r;
    s16x8 qf[4];
#pragma unroll
    for (int st = 0; st < 4; ++st) qf[st] = *(const GAS s16x8*)(proj + (size_t)qrow * DIN + PC_Q + (kv * 2 + g) * 64 + st * 16 + hh * 8);
    const float sinkl2 = sink4[kv * 2 + g] * 1.4426950409f, Mx = fmaxf(boundl2, sinkl2);
    f32x16 O[2]; float ls = 0.f;
#pragma unroll
    for (int dt = 0; dt < 2; ++dt)
#pragma unroll
        for (int i = 0; i < 16; ++i) O[dt][i] = 0.f;
    const int skey = F.tid >> 3, sch = F.tid & 7;
    int wt0 = 0, wt1 = 0;
    if (!ctxq) { wt0 = q0 < 128 ? (128 - q0 + 63) / 64 - ((128 - q0) % 64 ? 1 : 0) : 0; wt1 = 6; while (wt1 > 0 && q0 - 128 + 64 * (wt1 - 1) >= SEQ) --wt1; if (q0 - 128 + 64 * wt0 + 63 < 0) ++wt0; }
    const int ntiles = 4 + (wt1 - wt0);
    v4u kreg, vreg;
#define SW_LOAD_TILE(t) do { int krow_; if ((t) < 4) krow_ = M_LAT + b * 256 + (t) * 64 + skey; else { int kp_ = q0 - 128 + 64 * ((t) - 4 + wt0) + skey; kp_ = kp_ < 0 ? 0 : (kp_ >= SEQ ? SEQ - 1 : kp_); krow_ = b * 2048 + kp_; } \
        const bf16* pr_ = proj + (size_t)krow_ * DIN; kreg = *(const GAS v4u*)(pr_ + PC_K + kv * 64 + sch * 8); vreg = *(const GAS v4u*)(pr_ + PC_V + kv * 64 + sch * 8); } while (0)
#define SW_WRITE_TILE(bufi) do { *(LAS v4u*)(Kb + (bufi) * 9216 + skey * 144 + sch * 16) = kreg; \
        *(LAS v4u*)(Vb + (bufi) * 12288 + skey * 192 + sch * 16) = vreg; } while (0)
    SW_LOAD_TILE(0);
    __syncthreads();
    SW_WRITE_TILE(0);
    __syncthreads();
#pragma unroll 1
    for (int kt = 0; kt < ntiles; ++kt) {
        const int cur = kt & 1;
        if (kt + 1 < ntiles) SW_LOAD_TILE(kt + 1);
        const bool win = kt >= 4; const int kb = q0 - 128 + 64 * (kt - 4 + wt0);
#pragma unroll
        for (int blk = 0; blk < 2; ++blk) {
            const int kbb = kb + blk * 32;
            bool need_mask = false;
            if (win) { const int dmin = qp0 - (kbb + 31), dmax = qp0 + 31 - kbb;
                if (dmax < -128 || dmin > 128 || kbb + 31 < 0 || kbb >= SEQ) continue;
                need_mask = !(dmin >= -128 && dmax <= 128 && kbb >= 0 && kbb + 31 < SEQ); }
            f32x16 S;
#pragma unroll
            for (int i = 0; i < 16; ++i) S[i] = -Mx;
#pragma unroll
            for (int st = 0; st < 4; ++st) { const s16x8 kf = *(const LAS s16x8*)(Kb + cur * 9216 + (blk * 32 + r) * 144 + st * 32 + hh * 16); S = MFMA32(kf, qf[st], S); }
#pragma unroll
            for (int i = 0; i < 16; ++i) S[i] = __builtin_amdgcn_exp2f(S[i]);
            if (need_mask) { const int kp0 = kbb + 4 * hh, d0 = qp0 + r - kp0;
#pragma unroll
                for (int i = 0; i < 16; ++i) { const int c = (i & 3) + 8 * (i >> 2); const int d = d0 - c, kp = kp0 + c; S[i] = (d <= 128 && d >= -128 && kp >= 0 && kp < SEQ) ? S[i] : 0.f; } }
            ls = add1(ls, sum16(S));
#pragma unroll
            for (int s2 = 0; s2 < 2; ++s2) {
                v4u pw; pw.x = cvtpk_s(S[8 * s2 + 0], S[8 * s2 + 1]); pw.y = cvtpk_s(S[8 * s2 + 2], S[8 * s2 + 3]); pw.z = cvtpk_s(S[8 * s2 + 4], S[8 * s2 + 5]); pw.w = cvtpk_s(S[8 * s2 + 6], S[8 * s2 + 7]);
                const s16x8 pb = __builtin_bit_cast(s16x8, pw);
#pragma unroll
                for (int dt = 0; dt < 2; ++dt) { const LAS unsigned char* vb_ = Vb + cur * 12288;
                        const v2u lo = ds_tr16(VT_ADDR(vb_, blk * 32 + 16 * s2 + 4 * hh, dt * 32)), hi = ds_tr16(VT_ADDR(vb_, blk * 32 + 16 * s2 + 8 + 4 * hh, dt * 32));
                    v4u vw; vw.x = lo.x; vw.y = lo.y; vw.z = hi.x; vw.w = hi.y;
                    O[dt] = MFMA32(__builtin_bit_cast(s16x8, vw), pb, O[dt]); }
            }
        }
        if (kt + 1 < ntiles) SW_WRITE_TILE(cur ^ 1);
        __syncthreads();
    }
#undef SW_LOAD_TILE
#undef SW_WRITE_TILE
    const float inv = 1.f / (xor32_add(ls, lane) + __builtin_amdgcn_exp2f(sinkl2 - Mx));
#pragma unroll
    for (int dt = 0; dt < 2; ++dt)
#pragma unroll
        for (int g4 = 0; g4 < 4; ++g4) { const int dv0 = dt * 32 + 8 * g4 + 4 * hh;
            v2u o; o.x = pk2(O[dt][4 * g4] * inv, O[dt][4 * g4 + 1] * inv); o.y = pk2(O[dt][4 * g4 + 2] * inv, O[dt][4 * g4 + 3] * inv);
            *(GAS v2u*)(mix + (size_t)qrow * DM + 768 + (kv * 2 + g) * 64 + dv0) = o; }
}

constexpr int NSLOT = 24, S_N1 = 0, S_G1 = 1, S_PREP = 2, S_MIX = 3, S_HP = 4, S_G2 = 5, S_N2 = 6, S_MCV = 7, S_F = 8;
constexpr int NPHASES = 1 + DEPTH * NSLOT;
#define WGM_G1 16
#define WGM_F1 4
#define WGM_N1K 4
#ifndef DUP_MASK
#define DUP_MASK 0
#endif
#define DUPN(k) ((((DUP_MASK) >> (k)) & 1) + 1)
#ifndef MK_SINGLE
#define MK_SINGLE 1
#endif
struct Args { const float* in[24]; float* out; unsigned char* ws; int ph_lo, ph_hi, li, pad; };
#define WSB(off) ((bf16*)(WSP() + (off)))
#define WSF(off) ((float*)(WSP() + (off)))
__global__ void __launch_bounds__(NTHREADS, 2) mk_fwd(Args args) {
    extern __shared__ __attribute__((aligned(16))) unsigned char lds[];
    Frame F;
    F.lds = (LAS unsigned char*)lds; F.MISC = (volatile LAS unsigned*)(F.lds + LDSCTL_OFF);
    F.tid = threadIdx.x; F.lane = F.tid & 63; F.wave = __builtin_amdgcn_readfirstlane(F.tid >> 6);
    F.G = gridDim.x; { const int bx = blockIdx.x; F.vcu = (F.G % 8 == 0) ? (bx % 8) * (F.G / 8) + bx / 8 : bx; }
    for (int u = F.tid; u < (LDS_BYTES - LDSCTL_OFF) / 4; u += NTHREADS) ((LAS unsigned*)(F.lds + LDSCTL_OFF))[u] = 0u;
    __syncthreads();
    if (F.tid == 0) { volatile LAS unsigned long long* pt = (volatile LAS unsigned long long*)(F.lds + PTR_OFF);
#pragma unroll
        for (int i = 0; i < 24; ++i) pt[i] = (unsigned long long)args.in[i];
        pt[24] = (unsigned long long)args.out; pt[25] = (unsigned long long)args.ws; }
    __syncthreads();
    const int lo = args.ph_lo, hi = args.ph_hi;
    XcdBarrier bar; bar.bar = (unsigned*)(args.ws + WS_CTL) + CW_BAR; bar.x = 0; bar.st = nullptr;
    if (hi - lo > 1) bar = xcd_barrier_post((unsigned*)(args.ws + WS_CTL) + CW_BAR, F.MISC + 8);
    bool ran = false;
#define PH(id) if (lo <= (id) && (id) < hi)
#define REFRESH() do { int tz_ = threadIdx.x; asm volatile("" : "+v"(tz_)); F.tid = tz_; F.lane = tz_ & 63; F.wave = __builtin_amdgcn_readfirstlane(tz_ >> 6); } while (0)
#define SEAM() do { if (ran) { XcdBarrier b2_; b2_.bar = (unsigned*)(WSP() + WS_CTL) + CW_BAR; b2_.x = bar.x; b2_.st = bar.st; xcd_barrier(b2_); if (DUPN(7) > 1) xcd_barrier(b2_); } ran = true; int tz_ = threadIdx.x; asm volatile("" : "+v"(tz_)); F.tid = tz_; F.lane = tz_ & 63; F.wave = __builtin_amdgcn_readfirstlane(tz_ >> 6); } while (0)

    PH(0) { SEAM();
        for (int rep = 0; rep < DUPN(12); ++rep) {
        for (int rep2 = 0; rep2 < DUPN(13); ++rep2)
        mod_partial(F, INP(1), INP(3), INP(4), WSF(WS_BIG));
        for (int rep3 = 0; rep3 < DUPN(14); ++rep3) {
        LAS float* scr = (LAS float*)(F.lds + F.wave * 16640); int base = 0;
        for (int l = 0; l < DEPTH; ++l) tr_matrix(F, INP(8) + (size_t)l * DM * DIN, DM, DIN, WSB(WS_WINT) + (size_t)l * DIN * DM, 3, base, scr);
        for (int l = 0; l < DEPTH; ++l) tr_matrix(F, INP(9) + (size_t)l * DM * DM, DM, DM, WSB(WS_WOUTT) + (size_t)l * DM * DM, 0, base, scr);
        for (int j = 0; j < 2; ++j) { tr_matrix(F, INP(17) + (size_t)j * DM * DFF, DM, DFF, WSB(WS_W13T) + (size_t)j * 2 * DFF * DM, 1, base, scr);
            tr_matrix(F, INP(18) + (size_t)j * DM * DFF, DM, DFF, WSB(WS_W13T) + (size_t)j * 2 * DFF * DM, 2, base, scr);
            tr_matrix(F, INP(19) + (size_t)j * DFF * DM, DFF, DM, WSB(WS_W2T) + (size_t)j * DM * DFF, 0, base, scr); }
        __syncthreads(); }
        __syncthreads(); }
    }
    if (lo <= 0 && 0 < hi) { SEAM(); mod_finalize(F, WSF(WS_BIG), INP(5), WSF(WS_MOD), WSB(WS_SBF)); }
    for (int L = 0; L < DEPTH; ++L) {
        const int pb = 1 + L * NSLOT;
        if (pb + NSLOT <= lo || pb >= hi) continue;
        const bool need_ctx = L < DEPTH - 1; const int rows_post = need_ctx ? M_ALL : M_LAT;
#define XBL() (WSB(WS_XB))
#define XBC() (WSB(WS_XB) + (size_t)M_LAT * DM)
#define MODL() (WSF(WS_MOD) + (size_t)L * 33 * 6144)
        if (L == 0) PH(pb + S_N1) { SEAM();
            { float* GSC = WSF(WS_GSC); const float* MOD = WSF(WS_MOD); const float* gm = INP(6); const float* gf = INP(7);
#pragma unroll 1
              for (int i = F.vcu * NTHREADS + F.tid; i < 5 * 33 * 1024; i += F.G * NTHREADS) { const int t = i / (33 * 1024), rr = (i / 1024) % 33, cc = i & 1023; const int Lx = t < 3 ? t + 1 : 2 * (t - 3);
                  GSC[i] = (t < 3 ? gm[Lx * 1024 + cc] : gf[Lx * 1024 + cc]) * (1.f + MOD[((size_t)Lx * 33 + rr) * 6144 + (t < 3 ? 1024 : 4096) + cc]); } }
            for (int t = 0; t < 5; ++t) {
                const bool f1 = t >= 3; const int N = f1 ? 2 * DFF : DIN, off = f1 ? 45 + 22 * (t - 3) : 15 * t;
                pg8::Gemm g{WSB(WS_SBF) + (size_t)t * 256 * DM, f1 ? WSB(WS_W13T) + (size_t)(t - 3) * 2 * DFF * DM : WSB(WS_WINT) + (size_t)(t + 1) * DIN * DM, 256, N, DM};
                pg8::StaticOrder S; S.init(256, N, F.G, (int)((blockIdx.x + F.G - off) % F.G));
                pg8::EpiBias E{f1 ? WSF(WS_BF1) + (size_t)(2 * (t - 3)) * 33 * DFF : WSF(WS_BG1) + (size_t)t * 33 * DIN, WSF(WS_BF1) + (size_t)(2 * (t - 3) + 1) * 33 * DFF, f1 ? DFF : DIN, f1 ? 1 : 0};
                pg8::gemm_phase<pg8::EpiBias, pg8::StaticOrder, true, true>(F.lds + RING_OFF, g, S, E); }
            REFRESH();
            for (int rep = 0; rep < DUPN(0); ++rep) norm_phase<false, true>(F, INP(0), INP(2), XBL(), M_ALL, INP(6) + L * DM, MODL(), 0, 1, ACTP(), nullptr, nullptr, nullptr, nullptr); }
        PH(pb + S_G1) { SEAM();
            pg8::Gemm g{ACTP(), WSB(WS_WINT) + (size_t)L * DIN * DM, M_ALL, DIN, DM}; pg8::StaticOrder S; S.init(M_ALL, DIN, F.G, (int)blockIdx.x, WGM_G1);
            pg8::EpiStoreBf16 E{WSB(WS_BIG), DIN, L > 0 ? WSF(WS_SSP) : nullptr, WSF(WS_BG1) + (size_t)(L > 0 ? L - 1 : 0) * 33 * DIN, INP(10) + L * 64, INP(15) + L * 128, F.lane};
            for (int rep = 0; rep < DUPN(1); ++rep) pg8::gemm_phase<pg8::EpiStoreBf16, pg8::StaticOrder, true, true>(F.lds + RING_OFF, g, S, E); }
        PH(pb + S_MIX) { SEAM();
            const float lam_init = 0.8f - 0.6f * expf(-0.3f * (float)L);
            float lam, bound_da, bound_sw;
            { const int ln = F.lane; const float* lv = INP(11) + L * 128;
              const float d0 = wave_sum(ln < 32 ? lv[ln] * lv[32 + ln] : 0.f, ln), d1 = wave_sum(ln < 32 ? lv[64 + ln] * lv[96 + ln] : 0.f, ln);
              lam = expf(d0) - expf(d1) + lam_init;
              const float* g1 = INP(10) + L * 64; const float a1 = fabsf(g1[ln]);
              bound_da = 5.656854249f * 1.4426950409f * wave_max(ln < 32 ? a1 : 0.f, ln) * wave_max(ln >= 32 ? a1 : 0.f, ln);
              const float* g2 = INP(15) + L * 128;
              bound_sw = 8.f * 1.4426950409f * wave_max(fabsf(g2[ln]), ln) * wave_max(fabsf(g2[64 + ln]), ln); }
            for (int rep = 0; rep < DUPN(11); ++rep)
            for (int i = F.vcu; i < 256; i += F.G) hgrn_item(F, WSB(WS_BIG), i >> 3, (i >> 1) & 3, i & 1, INP(13), L, rep == DUPN(11) - 1);
            const int n_lat = 1024, n_it = n_lat + (need_ctx ? 128 : 0);
            REFRESH();
            for (int rep = 0; rep < DUPN(2); ++rep)
#pragma unroll 1
            for (int i = F.vcu; i < n_it; i += F.G) { const bool cq = i >= n_lat; const int j = i - n_lat;
                da_item(F, WSB(WS_BIG), ACTP(), cq ? (j >> 2) : (i >> 5), cq ? (j & 3) : ((i >> 3) & 3), cq ? 0 : (i & 7) * 256, cq, lam, lam_init, bound_da, INP(12) + L * 64); }
            REFRESH();
            for (int rep = 0; rep < DUPN(3); ++rep)
#pragma unroll 1
            for (int i = F.vcu; i < n_it; i += F.G) { const bool cq = i >= n_lat; const int j = i - n_lat;
                sw_item(F, WSB(WS_BIG), ACTP(), cq ? (j >> 2) : (i >> 5), cq ? ((j >> 1) & 1) : ((i >> 4) & 1), cq ? (j & 1) * 128 : (i & 15) * 128, cq, INP(16) + L * 4, bound_sw); }
        }
        PH(pb + S_HP) { SEAM(); for (int rep = 0; rep < DUPN(4); ++rep) hgrn_post_phase(F, WSB(WS_BIG), ACTP(), INP(14) + L * 128, rows_post); }
        PH(pb + S_G2) { SEAM();
            pg8::Gemm g{ACTP(), WSB(WS_WOUTT) + (size_t)L * DM * DM, rows_post, DM, DM}; pg8::StaticOrder S; S.init(rows_post, DM, F.G, (int)blockIdx.x, WGM_N1K);
            const bool dn = !(L & 1);
            pg8::EpiRes E{XBL(), XBL(), XBC(), XBC(), MODL() + 2 * DM, dn ? WSB(WS_ACT2) : nullptr, WSF(WS_GSC) + (size_t)(3 + (L >> 1)) * 33 * DM, WSF(WS_SSP), F.lane, (LAS float*)(F.lds + RING_BYTES)};
            pg8::gemm_phase<pg8::EpiRes, pg8::StaticOrder, true, true>(F.lds + RING_OFF, g, S, E); }
        if (L & 1) PH(pb + S_N2) { SEAM();
            for (int rep = 0; rep < DUPN(5); ++rep)
            norm_phase<true, false>(F, XBL(), XBC(), nullptr, rows_post, INP(7) + L * DM, MODL(), 3, 4, ACTP(), INP(20) + (size_t)(L >> 1) * DM * NEXP, (int*)WSF(WS_ROWINFO), (int*)WSF(WS_CNT), (int*)WSF(WS_TOK)); }
        if (!(L & 1)) {
            PH(pb + S_F) { SEAM();
                pg8::Gemm g{WSB(WS_ACT2), WSB(WS_W13T) + (size_t)(L >> 1) * 2 * DFF * DM, rows_post, 2 * DFF, DM}; pg8::StaticOrder S; S.init(rows_post, 2 * DFF, F.G, (int)blockIdx.x, WGM_F1);
                pg8::EpiSwiglu E{WSB(WS_BIG), DFF, WSF(WS_SSP), WSF(WS_BF1) + (size_t)(2 * (L >> 1)) * 33 * DFF, WSF(WS_BF1) + (size_t)(2 * (L >> 1) + 1) * 33 * DFF};
                for (int rep = 0; rep < DUPN(8); ++rep) pg8::gemm_phase<pg8::EpiSwiglu, pg8::StaticOrder, true, true>(F.lds + RING_OFF, g, S, E); }
            PH(pb + S_F + 1) { SEAM();
                pg8::Gemm g{WSB(WS_BIG), WSB(WS_W2T) + (size_t)(L >> 1) * DM * DFF, rows_post, DM, DFF}; pg8::StaticOrder S; S.init(rows_post, DM, F.G, (int)blockIdx.x, WGM_N1K);
                pg8::EpiRes E{XBL(), XBL(), XBC(), XBC(), MODL() + 5 * DM, ACTP(), WSF(WS_GSC) + (size_t)L * 33 * DM, WSF(WS_SSP), F.lane, (LAS float*)(F.lds + RING_BYTES)};
                pg8::gemm_phase<pg8::EpiRes, pg8::StaticOrder, true, true>(F.lds + RING_OFF, g, S, E); }
        } else {
            PH(pb + S_MCV) { SEAM();
                for (int rep = 0; rep < DUPN(10); ++rep) {
                LAS float* scr = (LAS float*)(F.lds + F.wave * 16640); int base = 0;
                for (int e = 0; e < NEXP; ++e) { const size_t eo = ((size_t)(L >> 1) * NEXP + e) * DM * DFF;
                    tr_matrix(F, INP(21) + eo, DM, DFF, WSB(WS_MW13T) + (size_t)e * 2 * DFF * DM, 1, base, scr);
                    tr_matrix(F, INP(22) + eo, DM, DFF, WSB(WS_MW13T) + (size_t)e * 2 * DFF * DM, 2, base, scr);
                    tr_matrix(F, INP(23) + eo, DFF, DM, WSB(WS_MW2T) + (size_t)e * DM * DFF, 0, base, scr); }
                moe_setup(F, (const int*)WSF(WS_CNT));
                moe_gather(F, 0, rows_post, ACTP(), WSB(WS_BIG), (const int*)WSF(WS_ROWINFO), (int*)WSF(WS_TOK), WSF(WS_WGT)); __syncthreads(); } }
            for (int st = 0; st < 2; ++st) {
                PH(pb + S_F + 2 * st) { SEAM();
                    moe_setup(F, (const int*)WSF(WS_CNT));
                    const volatile LAS int* segt = (const volatile LAS int*)(F.lds + SEGT_OFF) + st * 9; const int mp = __builtin_amdgcn_readfirstlane(segt[8]) * 256;
                    pg8::Gemm g{ACTP(), WSB(WS_MW13T), mp, 2 * DFF, DM}; pg8::GatherOrder S; S.init(mp, 2 * DFF, F.G, (int)blockIdx.x, WGM_F1); S.segt = segt; S.estride = (size_t)2 * DFF * DM * 2; S.tok = (const int*)WSF(WS_TOK) + st * MOE_MAXR;
                    pg8::EpiSwiglu E{WSB(WS_HIDM), DFF, nullptr, nullptr, nullptr};
                    for (int rep = 0; rep < DUPN(9); ++rep) pg8::gemm_phase<pg8::EpiSwiglu, pg8::GatherOrder, true, true>(F.lds + RING_OFF, g, S, E); }
                PH(pb + S_F + 2 * st + 1) { SEAM();
                    moe_setup(F, (const int*)WSF(WS_CNT));
                    if (st == 0) moe_gather(F, 1, rows_post, ACTP(), WSB(WS_BIG), (const int*)WSF(WS_ROWINFO), (int*)WSF(WS_TOK), WSF(WS_WGT));
                    __syncthreads();
                    const volatile LAS int* segt = (const volatile LAS int*)(F.lds + SEGT_OFF) + st * 9; const int mp = __builtin_amdgcn_readfirstlane(segt[8]) * 256;
                    pg8::Gemm g{WSB(WS_HIDM), WSB(WS_MW2T), mp, DM, DFF}; pg8::GroupedOrder S; S.init(mp, DM, F.G, (int)blockIdx.x, WGM_N1K); S.segt = segt; S.estride = (size_t)DM * DFF * 2;
                    pg8::EpiMoeRes E{XBL(), XBC(), MODL() + 5 * DM, (const int*)WSF(WS_TOK) + st * MOE_MAXR, WSF(WS_WGT) + st * MOE_MAXR, (st == 1 && need_ctx) ? ACTP() : nullptr, WSF(WS_GSC) + (size_t)L * 33 * DM, WSF(WS_SSP), F.lane, (LAS float*)(F.lds + RING_BYTES), st == 0 ? WSB(WS_BIG) : nullptr, st == 0 ? nullptr : WSB(WS_BIG), (st == 1 && !need_ctx) ? OUTP() : nullptr};
                    pg8::gemm_phase<pg8::EpiMoeRes, pg8::GroupedOrder, true, true>(F.lds + RING_OFF, g, S, E); }
            }
        }
    }
#undef PH
#undef SEAM
}

extern "C" void kernel_launch(void* const* d_in, const int* in_sizes, int n_in, void* d_out, int out_size, void* d_ws, size_t ws_size, hipStream_t stream) {
    static int grid = 0;
    if (grid == 0) {
        if (n_in != 24 || in_sizes[0] != M_LAT * DM || out_size != M_LAT * DM || ws_size < WS_END) { fprintf(stderr, "kernel_launch: unexpected shapes (n_in %d, in0 %d, out %d, ws %zu); nothing launched\n", n_in, n_in > 0 ? in_sizes[0] : -1, out_size, ws_size); grid = -1; return; }
        int dev = 0, cus = 0, per_cu = 0;
        if (hipGetDevice(&dev) != hipSuccess || hipDeviceGetAttribute(&cus, hipDeviceAttributeMultiprocessorCount, dev) != hipSuccess) { grid = -1; return; }
        if (hipFuncSetAttribute((const void*)mk_fwd, hipFuncAttributeMaxDynamicSharedMemorySize, LDS_BYTES) != hipSuccess) { fprintf(stderr, "kernel_launch: hipFuncSetAttribute failed\n"); grid = -1; return; }
        if (hipOccupancyMaxActiveBlocksPerMultiprocessor(&per_cu, (const void*)mk_fwd, NTHREADS, LDS_BYTES) != hipSuccess || per_cu < 1) fprintf(stderr, "kernel_launch: occupancy query reports %d\n", per_cu);
        (void)hipGetLastError();
        grid = cus;
    }
    if (grid < 0) return;
    if (hipMemsetAsync((char*)d_ws + WS_CTL, 0, CTL_ZERO_BYTES, stream) != hipSuccess) return;
    Args a{};
    for (int i = 0; i < 24; ++i) a.in[i] = (const float*)d_in[i];
    a.out = (float*)d_out; a.ws = (unsigned char*)d_ws; a.pad = 0;
#if MK_SINGLE
    a.ph_lo = 0; a.ph_hi = NPHASES; a.li = 0;
    hipLaunchKernelGGL(mk_fwd, dim3(grid), dim3(NTHREADS), LDS_BYTES, stream, a);
#else
    int li = 0;
    for (int p = 0; p < NPHASES; ++p) {
        if (p > 0) { const int L = (p - 1) / NSLOT, s = (p - 1) % NSLOT; const bool moe = L & 1;
            if (!moe && (s == S_MCV || s >= S_F + 2 || s == S_N2)) continue; if (moe && s >= S_F + 4) continue; if (L > 0 && s == S_N1) continue; }
        a.ph_lo = p; a.ph_hi = p + 1; a.li = 0; ++li;
        hipLaunchKernelGGL(mk_fwd, dim3(grid), dim3(NTHREADS), LDS_BYTES, stream, a);
    }
#endif
}
```
